# Optimizing an MI355X kernel written in HIP

```python
import jax, jax.numpy as jnp
from jax import lax
import numpy as np

D_MODEL = 2048
BATCH = 8
SEQ = 4096
DEPTH = 2

HA_Q = 8
HA_KV = 2
HEAD_DIM = 128
WINDOW = 128
BLOCK = 128
HB = 8
QK_NOPE = 128
QK_ROPE = 64
V_DIM = 128
Q_RANK = 512
KV_RANK = 512
D_FF = 5632
ROPE_THETA = 10000.0
EPS = 1e-6
N_MOD = 9

COLS_QA = HA_Q * HEAD_DIM
COLS_KA = HA_KV * HEAD_DIM
COLS_VA = HA_KV * HEAD_DIM
COLS_CQ = Q_RANK
COLS_CKV = KV_RANK
COLS_KR = QK_ROPE
COLS_GATE = 2 * D_MODEL
IN_SIZES = (COLS_QA, COLS_KA, COLS_VA, COLS_CQ, COLS_CKV, COLS_KR, COLS_GATE)
IN_COLS = sum(IN_SIZES)
IN_SPLITS = tuple(int(s) for s in np.cumsum(IN_SIZES)[:-1])

kernel_name = "hybrid_gated_swa_mla_macaron_adaln"


def rmsnorm(x, g):
    xf = x.astype(jnp.float32)
    y = xf * lax.rsqrt(jnp.mean(xf * xf, axis=-1, keepdims=True) + EPS)
    return (y * g.astype(jnp.float32)).astype(x.dtype)


def modulate(h, shift, scale):
    return h * (1 + scale[:, None, :]) + shift[:, None, :]


def rope_tables(positions, dim):
    freqs = ROPE_THETA ** (-jnp.arange(0, dim, 2, dtype=jnp.float32) / dim)
    ang = positions.astype(jnp.float32)[..., None] * freqs
    return jnp.cos(ang), jnp.sin(ang)


def apply_rope(x, cos, sin):
    xf = x.astype(jnp.float32)
    x1, x2 = jnp.split(xf, 2, axis=-1)
    return jnp.concatenate([x1 * cos - x2 * sin, x2 * cos + x1 * sin], axis=-1).astype(x.dtype)


def swiglu(h, w_gu, w_d):
    gu = h @ w_gu
    g, u = jnp.split(gu, 2, axis=-1)
    return (jax.nn.silu(g) * u) @ w_d


def window_gqa_sink(q, k, v, sink):
    B, S = q.shape[0], q.shape[1]
    nb = S // BLOCK
    G = HA_Q // HA_KV
    qb = q.reshape(B, nb, BLOCK, HA_KV, G, HEAD_DIM)
    pad = ((0, 0), (BLOCK, BLOCK), (0, 0), (0, 0))
    kp = jnp.pad(k, pad).reshape(B, nb + 2, BLOCK, HA_KV, HEAD_DIM)
    vp = jnp.pad(v, pad).reshape(B, nb + 2, BLOCK, HA_KV, HEAD_DIM)
    kb = jnp.concatenate([kp[:, :-2], kp[:, 1:-1], kp[:, 2:]], axis=2)
    vb = jnp.concatenate([vp[:, :-2], vp[:, 1:-1], vp[:, 2:]], axis=2)
    s = jnp.einsum('bnqhgd,bnkhd->bnhgqk', qb, kb).astype(jnp.float32) * (HEAD_DIM ** -0.5)
    r = jnp.arange(BLOCK)[:, None]
    j = jnp.arange(3 * BLOCK)[None, :]
    rel_ok = jnp.abs(j - BLOCK - r) <= WINDOW
    kpos = jnp.arange(nb)[:, None] * BLOCK - BLOCK + jnp.arange(3 * BLOCK)[None, :]
    pos_ok = (kpos >= 0) & (kpos < S)
    mask = rel_ok[None, :, :] & pos_ok[:, None, :]
    s = jnp.where(mask[None, :, None, None, :, :], s, -1e30)
    sk = sink.astype(jnp.float32).reshape(HA_KV, G)[None, None, :, :, None, None]
    m = jnp.maximum(jnp.max(s, axis=-1, keepdims=True), sk)
    p = jnp.exp(s - m)
    denom = jnp.sum(p, axis=-1, keepdims=True) + jnp.exp(sk - m)
    p = (p / denom).astype(v.dtype)
    o = jnp.einsum('bnhgqk,bnkhd->bnqhgd', p, vb)
    return o.reshape(B, S, HA_Q * HEAD_DIM)


def mla_attention(q_nope, q_rope, k_nope, k_rope, v):
    B, S = q_nope.shape[0], q_nope.shape[1]
    nb = S // BLOCK
    scale = (QK_NOPE + QK_ROPE) ** -0.5
    qn = q_nope.reshape(B, nb, BLOCK, HB, QK_NOPE).transpose(1, 0, 2, 3, 4)
    qr = q_rope.reshape(B, nb, BLOCK, HB, QK_ROPE).transpose(1, 0, 2, 3, 4)

    def one_block(args):
        qn_b, qr_b = args
        s = (jnp.einsum('bqhd,bkhd->bhqk', qn_b, k_nope)
             + jnp.einsum('bqhr,bkr->bhqk', qr_b, k_rope)).astype(jnp.float32) * scale
        p = jax.nn.softmax(s, axis=-1).astype(v.dtype)
        return jnp.einsum('bhqk,bkhd->bqhd', p, v)

    o = lax.map(one_block, (qn, qr))
    return o.transpose(1, 0, 2, 3, 4).reshape(B, S, HB * V_DIM)


def token_mixer(h, cos_a, sin_a, cos_r, sin_r, w_in, b_gate, sink, g_cq, g_ckv,
                w_uq, w_ukv, w_oa, w_ob, w_out):
    B, S, _ = h.shape
    qa, ka, va, cq, ckv, kr, gates = jnp.split(h @ w_in, IN_SPLITS, axis=-1)
    qa = apply_rope(qa.reshape(B, S, HA_Q, HEAD_DIM), cos_a, sin_a)
    ka = apply_rope(ka.reshape(B, S, HA_KV, HEAD_DIM), cos_a, sin_a)
    va = va.reshape(B, S, HA_KV, HEAD_DIM)
    y_a = window_gqa_sink(qa, ka, va, sink) @ w_oa
    q = (rmsnorm(cq, g_cq) @ w_uq).reshape(B, S, HB, QK_NOPE + QK_ROPE)
    q_nope, q_rope = q[..., :QK_NOPE], q[..., QK_NOPE:]
    q_rope = apply_rope(q_rope, cos_r[:, :, None, :], sin_r[:, :, None, :])
    kv = (rmsnorm(ckv, g_ckv) @ w_ukv).reshape(B, S, HB, QK_NOPE + V_DIM)
    k_nope, v_b = kv[..., :QK_NOPE], kv[..., QK_NOPE:]
    k_rope = apply_rope(kr, cos_r, sin_r)
    y_b = mla_attention(q_nope, q_rope, k_nope, k_rope, v_b) @ w_ob
    g_a, g_b = jnp.split(jax.nn.sigmoid(gates + b_gate), 2, axis=-1)
    return (g_a * y_a + g_b * y_b) @ w_out


def setup_inputs(seed: int = 0) -> dict:
    key = jax.random.key(seed)
    ks = jax.random.split(key, 24)
    f32 = jnp.float32
    D = D_MODEL

    def nrm(k, shape, s):
        return jax.random.normal(k, shape, f32) * s

    x = nrm(ks[0], (BATCH, SEQ, D), 1.0)
    c = nrm(ks[1], (BATCH, D), 1.0)
    offsets = jax.random.randint(ks[2], (BATCH, 1), 0, 1024, dtype=jnp.int32)
    positions = offsets + jnp.arange(SEQ, dtype=jnp.int32)[None, :]
    return {
        "x": x,
        "c": c,
        "positions": positions,
        "norm_g": 1.0 + nrm(ks[3], (DEPTH, 3, D), 0.1),
        "w_ada": nrm(ks[4], (DEPTH, D, N_MOD * D), 0.5 * D ** -0.5),
        "b_ada": nrm(ks[5], (DEPTH, N_MOD * D), 0.1),
        "w_ffn1_gu": nrm(ks[6], (DEPTH, D, 2 * D_FF), D ** -0.5),
        "w_ffn1_d": nrm(ks[7], (DEPTH, D_FF, D), D_FF ** -0.5),
        "w_ffn2_gu": nrm(ks[8], (DEPTH, D, 2 * D_FF), D ** -0.5),
        "w_ffn2_d": nrm(ks[9], (DEPTH, D_FF, D), D_FF ** -0.5),
        "w_in": nrm(ks[10], (DEPTH, D, IN_COLS), D ** -0.5),
        "b_gate": nrm(ks[11], (DEPTH, 2 * D), 0.1),
        "sink": nrm(ks[12], (DEPTH, HA_Q), 1.0),
        "g_cq": 1.0 + nrm(ks[13], (DEPTH, Q_RANK), 0.1),
        "g_ckv": 1.0 + nrm(ks[14], (DEPTH, KV_RANK), 0.1),
        "w_uq": nrm(ks[15], (DEPTH, Q_RANK, HB * (QK_NOPE + QK_ROPE)), Q_RANK ** -0.5),
        "w_ukv": nrm(ks[16], (DEPTH, KV_RANK, HB * (QK_NOPE + V_DIM)), KV_RANK ** -0.5),
        "w_oa": nrm(ks[17], (DEPTH, HA_Q * HEAD_DIM, D), (HA_Q * HEAD_DIM) ** -0.5),
        "w_ob": nrm(ks[18], (DEPTH, HB * V_DIM, D), (HB * V_DIM) ** -0.5),
        "w_out": nrm(ks[19], (DEPTH, D, D), D ** -0.5),
        "g_final": 1.0 + nrm(ks[20], (D,), 0.1),
    }


def reference(x, c, positions, norm_g, w_ada, b_ada, w_ffn1_gu, w_ffn1_d, w_ffn2_gu, w_ffn2_d,
              w_in, b_gate, sink, g_cq, g_ckv, w_uq, w_ukv, w_oa, w_ob, w_out, g_final):
    cos_a, sin_a = rope_tables(positions, HEAD_DIM)
    cos_a, sin_a = cos_a[:, :, None, :], sin_a[:, :, None, :]
    cos_r, sin_r = rope_tables(positions, QK_ROPE)
    c_act = jax.nn.silu(c)
    for l in range(DEPTH):
        sh1, sc1, gt1, sh2, sc2, gt2, sh3, sc3, gt3 = jnp.split(c_act @ w_ada[l] + b_ada[l], N_MOD, axis=-1)
        h = modulate(rmsnorm(x, norm_g[l, 0]), sh1, sc1)
        x = x + 0.5 * gt1[:, None, :] * swiglu(h, w_ffn1_gu[l], w_ffn1_d[l])
        h = modulate(rmsnorm(x, norm_g[l, 1]), sh2, sc2)
        x = x + gt2[:, None, :] * token_mixer(h, cos_a, sin_a, cos_r, sin_r, w_in[l], b_gate[l], sink[l],
                                              g_cq[l], g_ckv[l], w_uq[l], w_ukv[l], w_oa[l], w_ob[l], w_out[l])
        h = modulate(rmsnorm(x, norm_g[l, 2]), sh3, sc3)
        x = x + 0.5 * gt3[:, None, :] * swiglu(h, w_ffn2_gu[l], w_ffn2_d[l])
    return rmsnorm(x, g_final)
```

```cpp
#include <hip/hip_runtime.h>
#include <cstdio>
#include <cstdint>
#include <cmath>

#ifndef MERGE_MID
#define MERGE_MID true
#endif
#ifndef MK_ONE_LAUNCH
#define MK_ONE_LAUNCH 1
#endif

__device__ __forceinline__ int lane_id_fresh() { int l; asm volatile("v_mbcnt_lo_u32_b32 %0, -1, 0\n\tv_mbcnt_hi_u32_b32 %0, -1, %0" : "=v"(l)); return l; }

namespace pg8 {
#define PG8_LAS __attribute__((address_space(3)))
typedef unsigned short bf16_t;
typedef short bf16x8 __attribute__((ext_vector_type(8)));
typedef float f32x4 __attribute__((ext_vector_type(4)));
typedef unsigned u32x4 __attribute__((ext_vector_type(4)));
constexpr int BM = 256, BK = 64, HALF = 128, HTB = HALF * BK * 2  , STAGE_BYTES = 8 * HTB, NXCD = 8, WGM = 8;

__host__ __device__ __forceinline__ int lds_byte(int r, int c) { const int st = (r >> 4) * 2 + (c >> 5), rr = r & 15, cc = c & 31, ob = rr * 64 + cc * 2; return st * 1024 + (ob ^ (((ob >> 9) & 1) << 5)); }
__host__ __device__ __forceinline__ void stage_rc(int b, int& R, int& C) { const int st = b / 1024, sb = b % 1024, swz = sb ^ (((sb >> 9) & 1) << 5); R = (st >> 1) * 16 + swz / 64; C = (st & 1) * 32 + (swz % 64) / 2; }
__host__ __device__ __forceinline__ int perm32(int rho) { const int n = rho >> 4, i = rho & 15; return 8 * (i >> 2) + 4 * n + (i & 3); }

struct Unit { int pm, pn; };
struct Gemm { const bf16_t* A; const bf16_t* Bt; int M, N, K; };

struct StaticOrder {
    int nM, nN, nwg, G, c, wgm, rev;
    int pad_;
    __host__ __device__ void init(int M, int N, int G_, int c_, int wgm_ = WGM) { nM = M / BM; nN = N / BM; nwg = nM * nN; G = G_; c = c_; wgm = wgm_; rev = 0; pad_ = 0; }
    __host__ __device__ bool next(int i, Unit& u) const {
        const long L = (long)i * G + c; if (L >= nwg) return false;
        int wgid = (int)L; { const int q = nwg / NXCD, r = nwg % NXCD, xcd = wgid % NXCD, off = wgid / NXCD; wgid = (xcd < r ? xcd * (q + 1) : r * (q + 1) + (xcd - r) * q) + off; }
        const int nig = wgm * nN, gid = wgid / nig, fm = gid * wgm, gsz = (nM - fm) < wgm ? (nM - fm) : wgm;
        u.pm = fm + ((wgid % nig) % gsz); u.pn = (wgid % nig) / gsz; if (rev) u.pm = nM - 1 - u.pm; return true;
    }
    __device__ __forceinline__ void a_ready(const Unit&) const {}
    __device__ __forceinline__ void done(const Unit&) const {}
};
typedef __bf16 bf16x2_t __attribute__((ext_vector_type(2)));
__device__ __forceinline__ unsigned cvt_pk_bf16(float lo, float hi) { const float __attribute__((ext_vector_type(2))) v = {lo, hi}; return __builtin_bit_cast(unsigned, __builtin_convertvector(v, bf16x2_t)); }
typedef float f32x2 __attribute__((ext_vector_type(2)));
typedef unsigned u32x2 __attribute__((ext_vector_type(2)));
__device__ __forceinline__ float bf_lo(unsigned w) { return __uint_as_float(w << 16); }
__device__ __forceinline__ float bf_hi(unsigned w) { return __uint_as_float(w & 0xffff0000u); }
__device__ __forceinline__ float fast_sigmoid(float x) { return __builtin_amdgcn_rcpf(1.0f + __builtin_amdgcn_exp2f(-1.4426950408889634f * x)); }
__device__ __forceinline__ f32x2 fast_sigmoid2(f32x2 x) {
    const f32x2 t = x * (f32x2){-1.4426950408889634f, -1.4426950408889634f}; f32x2 e = {__builtin_amdgcn_exp2f(t.x), __builtin_amdgcn_exp2f(t.y)};
    e += (f32x2){1.0f, 1.0f}; return (f32x2){__builtin_amdgcn_rcpf(e.x), __builtin_amdgcn_rcpf(e.y)}; }
__device__ __forceinline__ u32x4 pack8(const f32x4 a, const f32x4 b) { u32x4 w; w.x = cvt_pk_bf16(a[0], a[1]); w.y = cvt_pk_bf16(a[2], a[3]); w.z = cvt_pk_bf16(b[0], b[1]); w.w = cvt_pk_bf16(b[2], b[3]); return w; }

struct EpiSwiglu {
    static constexpr bool PERM = true, AFTER_DRAIN = false, MID = false;
    bf16_t* O; int ldc;
    __device__ __forceinline__ void operator()(const f32x4 (&acc)[2][2][4][2], const Unit& u, int wr, int wc, int fr, int fq) const {
        const int row0 = u.pm * BM + wr * 64 + fr, col0 = u.pn * HALF + wc * 32 + 8 * fq;
#pragma unroll
        for (int ai = 0; ai < 2; ++ai)
#pragma unroll
            for (int m = 0; m < 4; ++m) { bf16_t* rowp = O + (size_t)(row0 + ai * HALF + m * 16) * ldc + col0;
                f32x4 v[2];
#pragma unroll
                for (int n = 0; n < 2; ++n) { const f32x4 g = acc[ai][0][m][n], up = acc[ai][1][m][n];
#pragma unroll
                    for (int i = 0; i < 4; i += 2) { const f32x2 g2 = {g[i], g[i + 1]}, o2 = g2 * fast_sigmoid2(g2) * (f32x2){up[i], up[i + 1]}; v[n][i] = o2.x; v[n][i + 1] = o2.y; } }
                *(u32x4*)rowp = pack8(v[0], v[1]); }
    }
};

struct EpiNull {
    static constexpr bool PERM = true, AFTER_DRAIN = false, MID = false;
    __device__ __forceinline__ void operator()(const f32x4 (&acc)[2][2][4][2], const Unit&, int, int, int, int) const {
#pragma unroll
        for (int ai = 0; ai < 2; ++ai)
#pragma unroll
            for (int bj = 0; bj < 2; ++bj)
#pragma unroll
                for (int m = 0; m < 4; ++m)
#pragma unroll
                    for (int n = 0; n < 2; ++n) asm volatile("" :: "v"(acc[ai][bj][m][n]));
    }
};

template <int MODE> struct EpiWinProbe {
    static constexpr bool PERM = true, AFTER_DRAIN = false, MID = false;
    bf16_t* DUMMY; const float* bgate;
    __device__ __forceinline__ void operator()(const f32x4 (&acc)[2][2][4][2], const Unit& u, int wr, int wc, int fr, int fq) const {
        const int row0 = u.pm * BM + wr * 64 + fr, pn = u.pn;
        if (pn < 11) {
#pragma unroll
            for (int ai = 0; ai < 2; ++ai)
#pragma unroll
                for (int bj = 0; bj < 2; ++bj)
#pragma unroll
                    for (int m = 0; m < 4; ++m)
#pragma unroll
                        for (int n = 0; n < 2; ++n) asm volatile("" :: "v"(acc[ai][bj][m][n]));
            return; }
        const int col0 = (pn - 11) * 256 + wc * 32 + 8 * fq;
        f32x4 bv[2][2];
#pragma unroll
        for (int bj = 0; bj < 2; ++bj)
#pragma unroll
            for (int n = 0; n < 2; ++n) bv[bj][n] = *(const f32x4*)(bgate + col0 + bj * HALF + 4 * n);
#pragma unroll
        for (int ai = 0; ai < 2; ++ai)
#pragma unroll
            for (int m = 0; m < 4; ++m) { bf16_t* rowp = DUMMY + (size_t)(row0 + ai * HALF + m * 16) * 2048 + (col0 & 2047);
#pragma unroll
                for (int bj = 0; bj < 2; ++bj) { f32x4 v[2];
#pragma unroll
                    for (int n = 0; n < 2; ++n) { const f32x4 t = acc[ai][bj][m][n] + bv[bj][n];
#pragma unroll
                        for (int i = 0; i < 4; ++i) v[n][i] = (MODE == 1) ? t[i] : fast_sigmoid(t[i]); }
                    if (MODE == 2) asm volatile("" :: "v"(v[0]), "v"(v[1])); else *(u32x4*)(rowp + bj * HALF) = pack8(v[0], v[1]); } }
    }
};

struct EpiResid {
    static constexpr bool PERM = true, AFTER_DRAIN = false, MID = false;
    const float* xin; float* out; const float* gate  ; float coef;
    __device__ __forceinline__ void operator()(const f32x4 (&acc)[2][2][4][2], const Unit& u, int wr, int wc, int fr, int fq) const {
        const int row0 = u.pm * BM + wr * 64 + fr, col0 = u.pn * BM + wc * 32 + 8 * fq;
        const float* gp = gate + (size_t)(u.pm >> 4) * 18432 + col0;
        f32x4 gv[2][2];
#pragma unroll
        for (int bj = 0; bj < 2; ++bj)
#pragma unroll
            for (int n = 0; n < 2; ++n) gv[bj][n] = *(const f32x4*)(gp + bj * HALF + n * 4) * coef;
#pragma unroll
        for (int ai = 0; ai < 2; ++ai)
#pragma unroll
            for (int m = 0; m < 4; ++m) { const size_t off = (size_t)(row0 + ai * HALF + m * 16) * 2048 + col0;
#pragma unroll
                for (int bj = 0; bj < 2; ++bj)
#pragma unroll
                    for (int n = 0; n < 2; ++n) { const f32x4 xv = *(const f32x4*)(xin + off + bj * HALF + n * 4);
                        *(f32x4*)(out + off + bj * HALF + n * 4) = xv + gv[bj][n] * acc[ai][bj][m][n]; } }
    }
};

struct EpiPlainBf16 {
    static constexpr bool PERM = true, AFTER_DRAIN = false, MID = false;
    bf16_t* O; int ldc;
    __device__ __forceinline__ void operator()(const f32x4 (&acc)[2][2][4][2], const Unit& u, int wr, int wc, int fr, int fq) const {
        const int row0 = u.pm * BM + wr * 64 + fr, col0 = u.pn * BM + wc * 32 + 8 * fq;
#pragma unroll
        for (int ai = 0; ai < 2; ++ai)
#pragma unroll
            for (int m = 0; m < 4; ++m) { bf16_t* rowp = O + (size_t)(row0 + ai * HALF + m * 16) * ldc + col0;
#pragma unroll
                for (int bj = 0; bj < 2; ++bj) *(u32x4*)(rowp + bj * HALF) = pack8(acc[ai][bj][m][0], acc[ai][bj][m][1]); }
    }
};

template <int NF> __device__ __forceinline__ void rope_store(const f32x4 (&acc)[2][2][4][2], int ai, int m, const float* cosT, const float* sinT, size_t row, int d0, bf16_t* o1p, bf16_t* o2p) {
    const f32x4 c0 = *(const f32x4*)(cosT + row * NF + d0), c1 = *(const f32x4*)(cosT + row * NF + d0 + 4);
    const f32x4 s0 = *(const f32x4*)(sinT + row * NF + d0), s1 = *(const f32x4*)(sinT + row * NF + d0 + 4);
    const f32x4 a0 = acc[ai][0][m][0], a1 = acc[ai][0][m][1], b0 = acc[ai][1][m][0], b1 = acc[ai][1][m][1];
    const f32x4 r0 = a0 * c0 - b0 * s0, r1 = a1 * c1 - b1 * s1, q0 = b0 * c0 + a0 * s0, q1 = b1 * c1 + a1 * s1;
    *(u32x4*)o1p = pack8(r0, r1); *(u32x4*)o2p = pack8(q0, q1);
}

struct EpiWin {
    static constexpr bool PERM = true, AFTER_DRAIN = false, MID = false;
    bf16_t *QA, *KA, *VA, *KR; unsigned char* GATES; bf16_t *CQN, *CKVN; float *SSQ, *SSKV; const float *gq, *gkv, *cosA, *sinA, *cosR, *sinR, *bgate;
    __device__ __forceinline__ void operator()(const f32x4 (&acc)[2][2][4][2], const Unit& u, int wr, int wc, int fr, int fq) const {
        const int row0 = u.pm * BM + wr * 64 + fr, pn = u.pn;
        if (pn <= 4) {
            const int hsel = wc >> 1, d0 = 32 * (wc & 1) + 8 * fq;
            bf16_t* base; int ld, head;
            if (pn < 4) { base = QA; ld = 2048; head = 2 * pn + hsel; } else { base = KA; ld = 256; head = hsel; }
#pragma unroll
            for (int ai = 0; ai < 2; ++ai)
#pragma unroll
                for (int m = 0; m < 4; ++m) { const size_t row = (size_t)(row0 + ai * HALF + m * 16); bf16_t* o1 = base + row * ld + head * 128 + d0;
                    rope_store<64>(acc, ai, m, cosA, sinA, row, d0, o1, o1 + 64); }
        } else if (pn == 5) {
            const int col0 = wc * 32 + 8 * fq;
#pragma unroll
            for (int ai = 0; ai < 2; ++ai)
#pragma unroll
                for (int m = 0; m < 4; ++m) { bf16_t* rowp = VA + (size_t)(row0 + ai * HALF + m * 16) * 256 + col0;
#pragma unroll
                    for (int bj = 0; bj < 2; ++bj) *(u32x4*)(rowp + bj * HALF) = pack8(acc[ai][bj][m][0], acc[ai][bj][m][1]); }
        } else if (pn <= 9) {
            bf16_t* base = pn <= 7 ? CQN : CKVN; float* ssp = pn <= 7 ? SSQ : SSKV; const float* gp = (pn <= 7 ? gq : gkv); const int col0 = ((pn - 6) & 1) * 256 + wc * 32 + 8 * fq;
            f32x4 gv[2][2];
#pragma unroll
            for (int bj = 0; bj < 2; ++bj)
#pragma unroll
                for (int n = 0; n < 2; ++n) gv[bj][n] = *(const f32x4*)(gp + col0 + bj * HALF + 4 * n);
#pragma unroll
            for (int ai = 0; ai < 2; ++ai)
#pragma unroll
                for (int m = 0; m < 4; ++m) { const size_t row = (size_t)(row0 + ai * HALF + m * 16); bf16_t* rowp = base + row * 512 + col0; float ssq = 0.f;
#pragma unroll
                    for (int bj = 0; bj < 2; ++bj) {
#pragma unroll
                        for (int n = 0; n < 2; ++n) { const f32x4 t = acc[ai][bj][m][n]; ssq += (t[0] * t[0] + t[1] * t[1]) + (t[2] * t[2] + t[3] * t[3]); }
                        *(u32x4*)(rowp + bj * HALF) = pack8(acc[ai][bj][m][0] * gv[bj][0], acc[ai][bj][m][1] * gv[bj][1]); }
                    { auto r = __builtin_amdgcn_permlane16_swap(__float_as_uint(ssq), __float_as_uint(ssq), false, false); ssq = __uint_as_float(r[0]) + __uint_as_float(r[1]); }
                    { auto r = __builtin_amdgcn_permlane32_swap(__float_as_uint(ssq), __float_as_uint(ssq), false, false); ssq = __uint_as_float(r[0]) + __uint_as_float(r[1]); }
                    if (fq == 0) unsafeAtomicAdd(ssp + row, ssq); }
        } else if (pn == 10) {
            if (wc == 0) { const int d0 = 8 * fq;
#pragma unroll
                for (int ai = 0; ai < 2; ++ai)
#pragma unroll
                    for (int m = 0; m < 4; ++m) { const size_t row = (size_t)(row0 + ai * HALF + m * 16); bf16_t* o1 = KR + row * 64 + d0;
                        rope_store<32>(acc, ai, m, cosR, sinR, row, d0, o1, o1 + 32); } }
        } else {
            const int col0 = (pn - 11) * 256 + wc * 32 + 8 * fq;
            f32x4 bv[2][2];
#pragma unroll
            for (int bj = 0; bj < 2; ++bj)
#pragma unroll
                for (int n = 0; n < 2; ++n) bv[bj][n] = *(const f32x4*)(bgate + col0 + bj * HALF + 4 * n);
#pragma unroll
            for (int ai = 0; ai < 2; ++ai)
#pragma unroll
                for (int m = 0; m < 4; ++m) { unsigned char* rowp = GATES + (size_t)(row0 + ai * HALF + m * 16) * 4096 + col0;
#pragma unroll
                    for (int bj = 0; bj < 2; ++bj) { u32x2 w;
#pragma unroll
                        for (int n = 0; n < 2; ++n) { const f32x4 t = acc[ai][bj][m][n] + bv[bj][n]; unsigned q[4];
#pragma unroll
                            for (int i = 0; i < 4; i += 2) { const f32x2 s2 = __builtin_elementwise_fma(fast_sigmoid2((f32x2){t[i], t[i + 1]}), (f32x2){255.0f, 255.0f}, (f32x2){8388608.0f, 8388608.0f});
                                q[i] = __float_as_uint(s2.x); q[i + 1] = __float_as_uint(s2.y); }
                            w[n] = __builtin_amdgcn_perm(q[1], q[0], 0x0c0c0400u) | __builtin_amdgcn_perm(q[3], q[2], 0x04000c0cu); }
                        *(u32x2*)(rowp + bj * HALF) = w; } }
        }
    }
};

__device__ __forceinline__ void row_rstd512(const float* ss, int row0, float (&rs)[2][4]) {
#pragma unroll
    for (int ai = 0; ai < 2; ++ai)
#pragma unroll
        for (int m = 0; m < 4; ++m) rs[ai][m] = 1.0f / sqrtf(ss[row0 + ai * HALF + m * 16] * (1.0f / 512.0f) + 1e-6f);
}
struct EpiUq {
    static constexpr bool PERM = true, AFTER_DRAIN = false, MID = false;
    bf16_t *QBN, *QBR; const float *cosR, *sinR, *ss;
    __device__ __forceinline__ void operator()(f32x4 (&acc)[2][2][4][2], const Unit& u, int wr, int wc, int fr, int fq) const {
        const int row0 = u.pm * BM + wr * 64 + fr, pn = u.pn;
        float rs[2][4]; row_rstd512(ss, row0, rs);
#pragma unroll
        for (int ai = 0; ai < 2; ++ai)
#pragma unroll
            for (int m = 0; m < 4; ++m)
#pragma unroll
                for (int bj = 0; bj < 2; ++bj)
#pragma unroll
                    for (int n = 0; n < 2; ++n) acc[ai][bj][m][n] = acc[ai][bj][m][n] * rs[ai][m];
        if (pn < 4) {
            const int col0 = pn * BM + wc * 32 + 8 * fq;
#pragma unroll
            for (int ai = 0; ai < 2; ++ai)
#pragma unroll
                for (int m = 0; m < 4; ++m) { bf16_t* rowp = QBN + (size_t)(row0 + ai * HALF + m * 16) * 2048 + col0;
#pragma unroll
                    for (int bj = 0; bj < 2; ++bj) *(u32x4*)(rowp + bj * HALF) = pack8(acc[ai][bj][m][0], acc[ai][bj][m][1]); }
        } else {
            const int head = 4 * (pn - 4) + wc, d0 = 8 * fq;
#pragma unroll
            for (int ai = 0; ai < 2; ++ai)
#pragma unroll
                for (int m = 0; m < 4; ++m) { const size_t row = (size_t)(row0 + ai * HALF + m * 16); bf16_t* o1 = QBR + row * 512 + head * 64 + d0;
                    rope_store<32>(acc, ai, m, cosR, sinR, row, d0, o1, o1 + 32); }
        }
    }
};
struct EpiScaledBf16 {
    static constexpr bool PERM = true, AFTER_DRAIN = false, MID = false;
    bf16_t* O; int ldc; const float* ss;
    __device__ __forceinline__ void operator()(const f32x4 (&acc)[2][2][4][2], const Unit& u, int wr, int wc, int fr, int fq) const {
        const int row0 = u.pm * BM + wr * 64 + fr, col0 = u.pn * BM + wc * 32 + 8 * fq;
        float rs[2][4]; row_rstd512(ss, row0, rs);
#pragma unroll
        for (int ai = 0; ai < 2; ++ai)
#pragma unroll
            for (int m = 0; m < 4; ++m) { bf16_t* rowp = O + (size_t)(row0 + ai * HALF + m * 16) * ldc + col0;
#pragma unroll
                for (int bj = 0; bj < 2; ++bj) *(u32x4*)(rowp + bj * HALF) = pack8(acc[ai][bj][m][0] * rs[ai][m], acc[ai][bj][m][1] * rs[ai][m]); }
    }
};

struct EpiGateMerge {
    static constexpr bool PERM = true, AFTER_DRAIN = false, MID = MERGE_MID;
    const unsigned char* G; bf16_t* O;
    static __device__ __forceinline__ f32x4 ub4(unsigned w) { return (f32x4){(float)(w & 0xffu), (float)((w >> 8) & 0xffu), (float)((w >> 16) & 0xffu), (float)(w >> 24)}; }
    __device__ __forceinline__ void mid(f32x4 (&acc)[2][2][4][2], const Unit& u, int wr, int wc, int fr_, int fq_) const {
        int fr = fr_, fq = fq_; asm volatile("" : "+v"(fr), "+v"(fq));
        const int row0 = u.pm * BM + wr * 64 + fr, col0 = u.pn * BM + wc * 32 + 8 * fq;
#pragma unroll
        for (int ai = 0; ai < 2; ++ai) {
            u32x2 ga[4][2], gb[4][2];
#pragma unroll
            for (int m = 0; m < 4; ++m) { const unsigned char* gp = G + (size_t)(row0 + ai * HALF + m * 16) * 4096 + col0;
#pragma unroll
                for (int bj = 0; bj < 2; ++bj) { ga[m][bj] = *(const u32x2*)(gp + bj * HALF); gb[m][bj] = *(const u32x2*)(gp + 2048 + bj * HALF); } }
#pragma unroll
            for (int m = 0; m < 4; ++m)
#pragma unroll
                for (int bj = 0; bj < 2; ++bj) { const u32x2 A = ga[m][bj], Bv = gb[m][bj];
                    const f32x4 a0 = ub4(A.x), a1 = ub4(A.y);
                    f32x4 b0 = ub4(Bv.x), b1 = ub4(Bv.y);
#pragma unroll
                    for (int i = 0; i < 4; ++i) { b0[i] = fmaxf(b0[i], 1e-30f); b1[i] = fmaxf(b1[i], 1e-30f); }
#pragma unroll
                    for (int i = 0; i < 4; ++i) { acc[ai][bj][m][0][i] *= a0[i] * __builtin_amdgcn_rcpf(b0[i]); acc[ai][bj][m][1][i] *= a1[i] * __builtin_amdgcn_rcpf(b1[i]); } }
            asm volatile("" ::: "memory");
        }
    }
    __device__ __forceinline__ void operator()(const f32x4 (&acc)[2][2][4][2], const Unit& u, int wr, int wc, int fr, int fq) const {
        const int row0 = u.pm * BM + wr * 64 + fr, col0 = u.pn * BM + wc * 32 + 8 * fq;
#pragma unroll
        for (int ai = 0; ai < 2; ++ai)
#pragma unroll
            for (int m = 0; m < 4; ++m) { const size_t row = (size_t)(row0 + ai * HALF + m * 16);
#pragma unroll
                for (int bj = 0; bj < 2; ++bj) { const int col = col0 + bj * HALF; const u32x2 gb = *(const u32x2*)(G + row * 4096 + 2048 + col);
                    f32x4 g0 = ub4(gb.x), g1 = ub4(gb.y);
#pragma unroll
                    for (int i = 0; i < 4; ++i) { g0[i] = fmaxf(g0[i], 1e-30f) * (1.0f / 255.0f); g1[i] = fmaxf(g1[i], 1e-30f) * (1.0f / 255.0f); }
                    const f32x4 v0 = acc[ai][bj][m][0] * g0, v1 = acc[ai][bj][m][1] * g1;
                    *(u32x4*)(O + row * 2048 + col) = pack8(v0, v1); } }
    }
};
template <class Epi, class Sched, bool ALIGN_EPI = false, bool SP2 = false>
__device__ __forceinline__ void gemm_phase(PG8_LAS unsigned char* lds, const Gemm g, const Sched& S, const Epi& E, const int wave_s) {
    int tid_ = wave_s * 64 + lane_id_fresh(); asm volatile("" : "+v"(tid_));
    const int tid = tid_, wid = __builtin_amdgcn_readfirstlane(tid >> 6), lane = tid & 63, wr = wid >> 2, wc = wid & 3, fr = lane & 15, fq = lane >> 4;
    const int K = g.K, nt = K / BK;
    unsigned voffA[2], voffB[2];
#pragma unroll
    for (int i = 0; i < 2; ++i) { int R, C; stage_rc(tid * 16 + i * 8192, R, C); const int Rb = Epi::PERM ? ((R & ~31) + perm32(R & 31)) : R;
        voffA[i] = (unsigned)(R * K + C) * 2u; voffB[i] = (unsigned)(Rb * K + C) * 2u; }
    const size_t kstep = (size_t)(BK * 2);
    const size_t hstep = (size_t)HALF * K * 2;
    const size_t tstep = 2 * hstep;
    const unsigned ldsw = (unsigned)wid * 1024u;
    const int aoff = lds_byte(wr * 64 + fr, fq * 8), boff = lds_byte(wc * 32 + fr, fq * 8);
#define PG8_SA(b, h) (((b) * 2 + (h)) * HTB)
#define PG8_SB(b, h) ((4 + (b) * 2 + (h)) * HTB)
#define PG8_STAGE(bufoff, gbase, voff) do { _Pragma("unroll") for (int _i = 0; _i < 2; ++_i) \
        __builtin_amdgcn_global_load_lds((const unsigned*)((const char*)(gbase) + (voff)[_i]), (PG8_LAS unsigned*)(lds + (bufoff) + ldsw + _i * 8192), 16, 0, 0); } while (0)
#define PG8_LDA(dst, b, h) do { _Pragma("unroll") for (int m = 0; m < 4; ++m) _Pragma("unroll") for (int k = 0; k < 2; ++k) dst[m][k] = *(const PG8_LAS bf16x8*)(lds + PG8_SA(b, h) + aoff + m * 2048 + k * 1024); } while (0)
#define PG8_LDB(dst, b, h) do { _Pragma("unroll") for (int n = 0; n < 2; ++n) _Pragma("unroll") for (int k = 0; k < 2; ++k) dst[n][k] = *(const PG8_LAS bf16x8*)(lds + PG8_SB(b, h) + boff + n * 2048 + k * 1024); } while (0)
#define PG8_MMA(ai, bj, At, Bt) do { __builtin_amdgcn_s_setprio(1); _Pragma("unroll") for (int m = 0; m < 4; ++m) _Pragma("unroll") for (int n = 0; n < 2; ++n) _Pragma("unroll") for (int k = 0; k < 2; ++k) \
        acc[ai][bj][m][n] = __builtin_amdgcn_mfma_f32_16x16x32_bf16(Bt[n][k], At[m][k], acc[ai][bj][m][n], 0, 0, 0); __builtin_amdgcn_s_setprio(0); } while (0)
#define PG8_WAIT_V(n) asm volatile("s_waitcnt vmcnt(" #n ")" ::: "memory")
#define PG8_WAIT_L(n) asm volatile("s_waitcnt lgkmcnt(" #n ")" ::: "memory")
#define PG8_BAR __builtin_amdgcn_s_barrier()
#define PG8_SCHED __builtin_amdgcn_sched_barrier(0)
    Unit cur, nxt; int ui = 0;
    if (!S.next(0, cur)) return;
    f32x4 acc[2][2][4][2];
#pragma unroll
    for (int a = 0; a < 2; ++a)
#pragma unroll
        for (int b = 0; b < 2; ++b)
#pragma unroll
            for (int m = 0; m < 4; ++m)
#pragma unroll
                for (int n = 0; n < 2; ++n) acc[a][b][m][n] = (f32x4){0.f, 0.f, 0.f, 0.f};
    bf16x8 At[4][2], B0[2][2], B1[2][2];
    const char* cA = (const char*)g.A + (size_t)cur.pm * tstep; const char* cB = (const char*)g.Bt + (size_t)cur.pn * tstep;
    S.a_ready(cur);
    if constexpr (SP2) {
        PG8_STAGE(PG8_SB(0, 0), cB, voffB); PG8_STAGE(PG8_SB(0, 1), cB + hstep, voffB); PG8_STAGE(PG8_SA(0, 0), cA, voffA); PG8_STAGE(PG8_SA(0, 1), cA + hstep, voffA);
        if (wr == 1) PG8_BAR;
        PG8_WAIT_V(2); PG8_BAR;
        PG8_STAGE(PG8_SB(1, 0), cB + kstep, voffB); PG8_STAGE(PG8_SA(1, 0), cA + kstep, voffA); PG8_STAGE(PG8_SB(1, 1), cB + hstep + kstep, voffB);
        PG8_WAIT_V(6); PG8_BAR;
    } else {
        PG8_STAGE(PG8_SB(0, 0), cB, voffB); PG8_STAGE(PG8_SA(0, 0), cA, voffA); PG8_STAGE(PG8_SB(0, 1), cB + hstep, voffB); PG8_STAGE(PG8_SA(0, 1), cA + hstep, voffA);
        if (wr == 1) PG8_BAR;
        PG8_WAIT_V(4); PG8_BAR;
        PG8_STAGE(PG8_SB(1, 0), cB + kstep, voffB); PG8_STAGE(PG8_SA(1, 0), cA + kstep, voffA); PG8_STAGE(PG8_SB(1, 1), cB + hstep + kstep, voffB);
        PG8_WAIT_V(6); PG8_BAR;
    }
    for (;;) {
        const bool has_next = S.next(ui + 1, nxt);
        const char* nA = has_next ? (const char*)g.A + (size_t)nxt.pm * tstep : cA; const char* nB = has_next ? (const char*)g.Bt + (size_t)nxt.pn * tstep : cB;
        for (int t = 0; t < nt; t += 2) {
            const bool last = (t == nt - 2);
            const char* a1 = cA + (size_t)(t + 1) * kstep;
            const char* a2 = last ? nA : cA + (size_t)(t + 2) * kstep; const char* b2 = last ? nB : cB + (size_t)(t + 2) * kstep;
            const char* a3 = a2 + kstep; const char* b3 = b2 + kstep;
            if (last && has_next) S.a_ready(nxt);
            if constexpr (SP2) {
            PG8_LDB(B0, 0, 0); PG8_LDB(B1, 0, 1); PG8_SCHED; PG8_LDA(At, 0, 0); PG8_STAGE(PG8_SA(1, 1), a1 + hstep, voffA);
            PG8_WAIT_V(8); PG8_WAIT_L(0); PG8_BAR; PG8_MMA(0, 0, At, B0); PG8_MMA(0, 1, At, B1); PG8_BAR; PG8_SCHED;
            PG8_LDA(At, 0, 1); PG8_STAGE(PG8_SB(0, 0), b2, voffB); PG8_STAGE(PG8_SB(0, 1), b2 + hstep, voffB); PG8_STAGE(PG8_SA(0, 0), a2, voffA);
            PG8_WAIT_V(8); PG8_WAIT_L(0); PG8_BAR; PG8_MMA(1, 0, At, B0); PG8_MMA(1, 1, At, B1); PG8_BAR; PG8_SCHED;
            PG8_LDB(B0, 1, 0); PG8_LDB(B1, 1, 1); PG8_SCHED; PG8_LDA(At, 1, 0); PG8_STAGE(PG8_SA(0, 1), a2 + hstep, voffA);
            PG8_WAIT_V(8); PG8_WAIT_L(0); PG8_BAR; PG8_MMA(0, 0, At, B0); PG8_MMA(0, 1, At, B1); PG8_BAR; PG8_SCHED;
            PG8_LDA(At, 1, 1); PG8_STAGE(PG8_SB(1, 0), b3, voffB); PG8_STAGE(PG8_SB(1, 1), b3 + hstep, voffB); PG8_STAGE(PG8_SA(1, 0), a3, voffA);
            PG8_WAIT_V(8); PG8_WAIT_L(0); PG8_BAR; PG8_MMA(1, 0, At, B0); PG8_MMA(1, 1, At, B1); PG8_BAR; PG8_SCHED;
            } else {
            PG8_LDB(B0, 0, 0); PG8_SCHED; PG8_LDA(At, 0, 0); PG8_STAGE(PG8_SA(1, 1), a1 + hstep, voffA);
            PG8_WAIT_L(8); PG8_BAR; PG8_WAIT_L(0); PG8_MMA(0, 0, At, B0); PG8_BAR; PG8_SCHED;
            PG8_LDB(B1, 0, 1); PG8_STAGE(PG8_SB(0, 0), b2, voffB);
            PG8_BAR; PG8_WAIT_L(0); PG8_MMA(0, 1, At, B1); PG8_BAR;
            PG8_LDA(At, 0, 1); PG8_STAGE(PG8_SA(0, 0), a2, voffA);
            PG8_BAR; PG8_WAIT_L(0); PG8_MMA(1, 0, At, B0); PG8_BAR; PG8_SCHED;
            PG8_STAGE(PG8_SB(0, 1), b2 + hstep, voffB);
            PG8_WAIT_V(6); PG8_BAR; PG8_MMA(1, 1, At, B1); PG8_BAR;
            PG8_LDB(B0, 1, 0); PG8_SCHED; PG8_LDA(At, 1, 0); PG8_STAGE(PG8_SA(0, 1), a2 + hstep, voffA);
            PG8_WAIT_L(8); PG8_BAR; PG8_WAIT_L(0); PG8_MMA(0, 0, At, B0); PG8_BAR; PG8_SCHED;
            PG8_LDB(B1, 1, 1); PG8_STAGE(PG8_SB(1, 0), b3, voffB);
            PG8_BAR; PG8_WAIT_L(0); PG8_MMA(0, 1, At, B1); PG8_BAR;
            PG8_LDA(At, 1, 1); PG8_STAGE(PG8_SA(1, 0), a3, voffA);
            PG8_BAR; PG8_WAIT_L(0); PG8_MMA(1, 0, At, B0); PG8_BAR; PG8_SCHED;
            PG8_STAGE(PG8_SB(1, 1), b3 + hstep, voffB);
            PG8_WAIT_V(6); PG8_BAR; PG8_MMA(1, 1, At, B1); PG8_BAR;
            }
            if constexpr (Epi::MID) { if (t == nt / 2 - 2) { PG8_SCHED; E.mid(acc, cur, wr, wc, fr, fq); PG8_SCHED; } }
        }
        if constexpr (ALIGN_EPI) { if (wr == 0) PG8_BAR; }
        if constexpr (!Epi::AFTER_DRAIN) { E(acc, cur, wr, wc, fr, fq); S.done(cur); }
        if (!has_next) break;
#pragma unroll
        for (int a = 0; a < 2; ++a)
#pragma unroll
            for (int b = 0; b < 2; ++b)
#pragma unroll
                for (int m = 0; m < 4; ++m)
#pragma unroll
                    for (int n = 0; n < 2; ++n) acc[a][b][m][n] = (f32x4){0.f, 0.f, 0.f, 0.f};
        cur = nxt; cA = nA; cB = nB; ++ui;
        if constexpr (ALIGN_EPI) { if (wr == 1) PG8_BAR; }
    }
    PG8_WAIT_V(0);
    if constexpr (!ALIGN_EPI) { if (wr == 0) PG8_BAR; }
    PG8_BAR;
    if constexpr (Epi::AFTER_DRAIN) { E.fused(acc, cur, wr, wc, fr, fq, lds, wid, lane); S.done(cur); }
#undef PG8_SA
#undef PG8_SB
#undef PG8_STAGE
#undef PG8_LDA
#undef PG8_LDB
#undef PG8_MMA
#undef PG8_WAIT_V
#undef PG8_WAIT_L
#undef PG8_BAR
#undef PG8_SCHED
}
}
namespace att {
typedef unsigned short bf16;
using bf16x8 = __attribute__((ext_vector_type(8))) short;
using s16x4  = __attribute__((ext_vector_type(4))) short;
using f32x16 = __attribute__((ext_vector_type(16))) float;
using u32x4  = __attribute__((ext_vector_type(4))) unsigned;
using f32x2  = __attribute__((ext_vector_type(2))) float;
constexpr int NW = 8, QBLK = 32, KVBLK = 64;
constexpr int SHM_V = KVBLK * 128 * 2, SHM_K = KVBLK * 128 * 2, SHM_KR = KVBLK * 64 * 2;
constexpr int OFF_V = 0, OFF_K = 2 * SHM_V, OFF_KR = OFF_K + 2 * SHM_K, OFF_WS = OFF_KR + 2 * SHM_KR, OFF_QR = OFF_WS + NW * 64 * 4, ATT_LDS = OFF_QR + NW * 4096;
constexpr int O3_V = 0, O3_K = 3 * SHM_V, O3_KR = O3_K + 3 * SHM_K, O3_WS = O3_KR + 3 * SHM_KR, O3_QR = O3_WS + NW * 64 * 4, ATT3_LDS = O3_QR + NW * 4096;
constexpr int S4_V = 0, S4_K = 4 * SHM_V, S4_KR = S4_K + 3 * SHM_K, S4_WS = S4_KR + 3 * SHM_KR, ATT4_LDS = S4_WS + NW * 64 * 4;
#define KSWZ(row, colB) ((row) * 256 + ((colB) ^ (((row) & 15) << 4)))
#define KRSWZ(row, colB) ((row) * 128 + ((colB) ^ ((((row) >> 1) & 7) << 4)))
#define SBAR() __builtin_amdgcn_sched_barrier(0)
__device__ __forceinline__ int crow(int r, int hi) { return (r & 3) + 8 * (r >> 2) + 4 * hi; }
typedef __bf16 bf16x2_t __attribute__((ext_vector_type(2)));
__device__ __forceinline__ unsigned cvtpk(float lo, float hi) { const float __attribute__((ext_vector_type(2))) v = {lo, hi}; return __builtin_bit_cast(unsigned, __builtin_convertvector(v, bf16x2_t)); }

template <bool MASK> __device__ __forceinline__ void partialSM(f32x16& p0, f32x16& p1, float& m_reg, float& mn, float& alpha, const float C, const float THRR, int qi, int kb, int hi) {
  if (MASK) {
    int t = qi - 128 - kb - 4 * hi; asm volatile("" : "+v"(t));
#pragma unroll
    for (int r = 0; r < 16; ++r) { const int cr = (r & 3) + 8 * (r >> 2);
      p0[r] = ((unsigned)(cr - t) <= 256u) ? p0[r] : -__builtin_inff();
      p1[r] = ((unsigned)(cr + 32 - t) <= 256u) ? p1[r] : -__builtin_inff(); }
  }
  float pmax = p0[0];
#pragma unroll
  for (int r = 1; r < 16; ++r) pmax = fmaxf(pmax, p0[r]);
#pragma unroll
  for (int r = 0; r < 16; ++r) pmax = fmaxf(pmax, p1[r]);
  { auto rr = __builtin_amdgcn_permlane32_swap(__float_as_uint(pmax), __float_as_uint(pmax), false, false);
    pmax = fmaxf(__uint_as_float(rr[0]), __uint_as_float(rr[1])); }
  if (__builtin_expect(__all(pmax - m_reg <= THRR), 1)) { mn = m_reg; alpha = 1.f; }
  else { mn = fmaxf(m_reg, pmax); alpha = __builtin_amdgcn_exp2f((m_reg - mn) * C); m_reg = mn; }
  const float mnC = -mn * C; const f32x2 C2 = {C, C}, mnC2 = {mnC, mnC};
#pragma unroll
  for (int r = 0; r < 16; r += 2) { const f32x2 t = __builtin_elementwise_fma((f32x2){p0[r], p0[r + 1]}, C2, mnC2); p0[r] = t.x; p0[r + 1] = t.y; }
#pragma unroll
  for (int r = 0; r < 16; r += 2) { const f32x2 t = __builtin_elementwise_fma((f32x2){p1[r], p1[r + 1]}, C2, mnC2); p1[r] = t.x; p1[r + 1] = t.y; }
#pragma unroll
  for (int r = 0; r < 16; ++r) p0[r] = __builtin_amdgcn_exp2f(p0[r]);
}
__device__ __forceinline__ void finishSM(f32x16& p0, f32x16& p1, float alpha, float& l_reg, bf16x8& pa0, bf16x8& pa1, bf16x8& pa2, bf16x8& pa3) {
#pragma unroll
  for (int r = 0; r < 16; ++r) p1[r] = __builtin_amdgcn_exp2f(p1[r]);
  f32x2 ps2 = {p0[0], p0[1]};
#pragma unroll
  for (int r = 2; r < 16; r += 2) ps2 += (f32x2){p0[r], p0[r + 1]};
#pragma unroll
  for (int r = 0; r < 16; r += 2) ps2 += (f32x2){p1[r], p1[r + 1]};
  float ps = ps2.x + ps2.y;
  { auto rr = __builtin_amdgcn_permlane32_swap(__float_as_uint(ps), __float_as_uint(ps), false, false);
    ps = __uint_as_float(rr[0]) + __uint_as_float(rr[1]); }
  l_reg = l_reg * alpha + ps;
#define PK4(P, BASE, OUT) do { unsigned a0 = cvtpk(P[BASE + 0], P[BASE + 1]), a1 = cvtpk(P[BASE + 2], P[BASE + 3]);   \
    unsigned b0 = cvtpk(P[BASE + 4], P[BASE + 5]), b1 = cvtpk(P[BASE + 6], P[BASE + 7]);                              \
    auto r0 = __builtin_amdgcn_permlane32_swap(a0, b0, false, false); auto r1 = __builtin_amdgcn_permlane32_swap(a1, b1, false, false); \
    u32x4 w = {r0[0], r1[0], r0[1], r1[1]}; OUT = *reinterpret_cast<bf16x8*>(&w); } while (0)
  PK4(p0, 0, pa0); PK4(p0, 8, pa1); PK4(p1, 0, pa2); PK4(p1, 8, pa3);
#undef PK4
}
template <int NR> __device__ __forceinline__ void qkt(f32x16& p0, f32x16& p1, const char* Ks, const char* KRs, const bf16x8* qr, const char* qrl, int r32, int hi) {
  p0 = f32x16{}; p1 = f32x16{};
#pragma unroll
  for (int d0 = 0; d0 < 8; ++d0) { const int cb = (d0 * 16 + hi * 8) * 2;
    const bf16x8 b0 = *reinterpret_cast<const bf16x8*>(Ks + KSWZ(r32, cb));
    const bf16x8 b1 = *reinterpret_cast<const bf16x8*>(Ks + KSWZ(32 + r32, cb));
    p0 = __builtin_amdgcn_mfma_f32_32x32x16_bf16(b0, qr[d0], p0, 0, 0, 0);
    p1 = __builtin_amdgcn_mfma_f32_32x32x16_bf16(b1, qr[d0], p1, 0, 0, 0); }
#pragma unroll
  for (int d0 = 0; d0 < NR; ++d0) { const int cb = (d0 * 16 + hi * 8) * 2;
    const bf16x8 b0 = *reinterpret_cast<const bf16x8*>(KRs + KRSWZ(r32, cb));
    const bf16x8 b1 = *reinterpret_cast<const bf16x8*>(KRs + KRSWZ(32 + r32, cb));
    const bf16x8 qf = *reinterpret_cast<const bf16x8*>(qrl + d0 * 1024);
    p0 = __builtin_amdgcn_mfma_f32_32x32x16_bf16(b0, qf, p0, 0, 0, 0);
    p1 = __builtin_amdgcn_mfma_f32_32x32x16_bf16(b1, qf, p1, 0, 0, 0); }
}
__device__ __forceinline__ int v_st(int k, int c) { const int kk = (k & ~0xC) | ((k & 4) << 1) | ((k & 8) >> 1); return ((kk >> 3) * 4 + (c >> 5)) * 512 + ((kk & 7) * 32 + (c & 31)) * 2; }
__device__ __forceinline__ int v_rd_base(int lane) { return ((lane & 3) << 3) | (((lane >> 2) & 3) << 6) | (((lane >> 4) & 1) << 5) | (((lane >> 5) & 1) << 8); }
constexpr int v_rd_off(int d0, int ks, int half) { return d0 * 512 + ks * 4096 + half * 2048; }
template <int OFF> __device__ __forceinline__ s16x4 tr_read(int vb) { s16x4 r; asm volatile("ds_read_b64_tr_b16 %0, %1 offset:%2" : "=&v"(r) : "v"(vb), "i"(OFF) : "memory"); return r; }
template <int D0> __device__ __forceinline__ void pv_one(f32x16& od, int vb, bf16x8 pa0, bf16x8 pa1, bf16x8 pa2, bf16x8 pa3) {
  const s16x4 l0 = tr_read<v_rd_off(D0, 0, 0)>(vb), h0 = tr_read<v_rd_off(D0, 0, 1)>(vb), l1 = tr_read<v_rd_off(D0, 1, 0)>(vb), h1 = tr_read<v_rd_off(D0, 1, 1)>(vb);
  const s16x4 l2 = tr_read<v_rd_off(D0, 2, 0)>(vb), h2 = tr_read<v_rd_off(D0, 2, 1)>(vb), l3 = tr_read<v_rd_off(D0, 3, 0)>(vb), h3 = tr_read<v_rd_off(D0, 3, 1)>(vb);
  asm volatile("s_waitcnt lgkmcnt(0)" ::: "memory"); SBAR();
#define PK(L, H) (bf16x8){L[0], L[1], L[2], L[3], H[0], H[1], H[2], H[3]}
  od = __builtin_amdgcn_mfma_f32_32x32x16_bf16(pa0, PK(l0, h0), od, 0, 0, 0);
  od = __builtin_amdgcn_mfma_f32_32x32x16_bf16(pa1, PK(l1, h1), od, 0, 0, 0);
  od = __builtin_amdgcn_mfma_f32_32x32x16_bf16(pa2, PK(l2, h2), od, 0, 0, 0);
  od = __builtin_amdgcn_mfma_f32_32x32x16_bf16(pa3, PK(l3, h3), od, 0, 0, 0);
#undef PK
}
__device__ __forceinline__ void pv_d0(f32x16* o, int vb, bf16x8 pa0, bf16x8 pa1, bf16x8 pa2, bf16x8 pa3) {
  pv_one<0>(o[0], vb, pa0, pa1, pa2, pa3); pv_one<1>(o[1], vb, pa0, pa1, pa2, pa3); pv_one<2>(o[2], vb, pa0, pa1, pa2, pa3); pv_one<3>(o[3], vb, pa0, pa1, pa2, pa3);
}

template <bool MLA, int LDQ, int LDQR, int LDK, int SD>
__device__ __forceinline__ void attn_body(const bf16* Qb, const bf16* Qrb, const bf16* __restrict__ Kh, const bf16* __restrict__ Vh, const bf16* __restrict__ KRh,
                                          bf16* Ob, int NT, const float C, const float THRR, const float m0, const float l0, int q0, int kb0, char* lds, const int wave_s) {
  constexpr int NR = MLA ? 4 : 0, NLD = MLA ? 5 : 4;
  int tid_ = wave_s * 64 + lane_id_fresh(); asm volatile("" : "+v"(tid_));
  const int tid = tid_, wid = tid >> 6, lane = tid & 63, r32 = lane & 31, hi = lane >> 5;
  char* V_lds = lds + OFF_V; char* K_lds = lds + OFF_K; char* KR_lds = lds + OFF_KR;
  float* wsf = (float*)(lds + OFF_WS) + wid * 64; float* li_l = wsf; float* al_l = wsf + 32;
  float m_reg = m0, l_reg = l0; f32x16 o[4] = {}; bf16x8 qr[8];
  const bf16* Qw = Qb + (long)(wid * QBLK + r32) * LDQ + hi * 8;
#pragma unroll
  for (int d0 = 0; d0 < 8; ++d0) qr[d0] = *reinterpret_cast<const bf16x8*>(Qw + d0 * 16);
  const char* qrl = lds + OFF_QR + wid * 4096 + lane * 16;
  if (MLA) { const bf16* Qrw = Qrb + (long)(wid * QBLK + r32) * LDQR + hi * 8;
#pragma unroll
    for (int d0 = 0; d0 < NR; ++d0) *(bf16x8*)(lds + OFF_QR + wid * 4096 + lane * 16 + d0 * 1024) = *reinterpret_cast<const bf16x8*>(Qrw + d0 * 16); }
  const int qi = q0 + wid * QBLK + r32;
  const int sr = tid >> 4, sc = (tid & 15) * 8, vst0 = v_st(sr, sc), vst1 = v_st(32 + sr, sc);
  const int krr = tid >> 3, krc = (tid & 7) * 8;
  const int vb0 = (int)(uintptr_t)V_lds + v_rd_base(lane);
  struct { bf16x8 vs0, vs1, ks0, ks1, kr; } sr_[SD];
#define SLOAD(i, k0) do { sr_[i].vs0 = *reinterpret_cast<const bf16x8*>(&Vh[(long)((k0) + sr) * LDK + sc]); sr_[i].vs1 = *reinterpret_cast<const bf16x8*>(&Vh[(long)((k0) + 32 + sr) * LDK + sc]); \
    sr_[i].ks0 = *reinterpret_cast<const bf16x8*>(&Kh[(long)((k0) + sr) * LDK + sc]); sr_[i].ks1 = *reinterpret_cast<const bf16x8*>(&Kh[(long)((k0) + 32 + sr) * LDK + sc]); \
    if (MLA) sr_[i].kr = *reinterpret_cast<const bf16x8*>(&KRh[(long)((k0) + krr) * 64 + krc]); } while (0)
#define SWRITE(b, i) do { *(bf16x8*)(V_lds + (b) * SHM_V + vst0) = sr_[i].vs0; *(bf16x8*)(V_lds + (b) * SHM_V + vst1) = sr_[i].vs1; const int kc = sc * 2; \
    *(bf16x8*)(K_lds + (b) * SHM_K + KSWZ(sr, kc)) = sr_[i].ks0; *(bf16x8*)(K_lds + (b) * SHM_K + KSWZ(32 + sr, kc)) = sr_[i].ks1; \
    if (MLA) *(bf16x8*)(KR_lds + (b) * SHM_KR + KRSWZ(krr, krc * 2)) = sr_[i].kr; } while (0)
#define SWAIT() do { if (SD == 1) asm volatile("s_waitcnt vmcnt(0)" ::: "memory"); else if (MLA) asm volatile("s_waitcnt vmcnt(5)" ::: "memory"); else asm volatile("s_waitcnt vmcnt(4)" ::: "memory"); } while (0)
#define RESC(a) do { if (__any((a) < 1.f)) { if (hi == 0) al_l[r32] = (a); asm volatile("s_waitcnt lgkmcnt(0)" ::: "memory"); \
    _Pragma("unroll") for (int d = 0; d < 4; ++d) _Pragma("unroll") for (int r = 0; r < 16; ++r) o[d][r] *= al_l[crow(r, hi)]; } } while (0)
  f32x16 pA0, pA1, pB0, pB1; float mnA, mnB, alA, alB; bf16x8 pa0, pa1, pa2, pa3;
  constexpr int SE = 0, SO = SD - 1;
  SLOAD(SE, 0); asm volatile("s_waitcnt vmcnt(0)" ::: "memory"); SWRITE(0, SE); __syncthreads();
  qkt<NR>(pA0, pA1, K_lds, KR_lds, qr, qrl, r32, hi); partialSM<!MLA>(pA0, pA1, m_reg, mnA, alA, C, THRR, qi, kb0, hi);
  SLOAD(SO, KVBLK); if (SD == 2) { if (2 < NT) SLOAD(SE, 2 * KVBLK); }
  SWAIT(); SWRITE(1, SO); __syncthreads();
  for (int j = 1; j + 1 < NT; j += 2) {
    SBAR(); qkt<NR>(pB0, pB1, K_lds + SHM_K, KR_lds + SHM_KR, qr, qrl, r32, hi);
    finishSM(pA0, pA1, alA, l_reg, pa0, pa1, pa2, pa3); SBAR();
    SLOAD(SO, (j + SD) * KVBLK); SBAR();
    pv_d0(o, vb0, pa0, pa1, pa2, pa3); partialSM<!MLA>(pB0, pB1, m_reg, mnB, alB, C, THRR, qi, kb0 + j * KVBLK, hi);
    __syncthreads(); SWAIT(); SWRITE(0, SE);
    RESC(alB); __syncthreads();
    SBAR(); qkt<NR>(pA0, pA1, K_lds, KR_lds, qr, qrl, r32, hi);
    finishSM(pB0, pB1, alB, l_reg, pa0, pa1, pa2, pa3); SBAR();
    if (SD == 1 || j + 3 < NT) SLOAD(SE, (j + 1 + SD) * KVBLK); SBAR();
    pv_d0(o, vb0 + SHM_V, pa0, pa1, pa2, pa3); partialSM<!MLA>(pA0, pA1, m_reg, mnA, alA, C, THRR, qi, kb0 + (j + 1) * KVBLK, hi);
    __syncthreads(); SWAIT(); SWRITE(1, SO);
    RESC(alA); __syncthreads();
  }
  SBAR(); qkt<NR>(pB0, pB1, K_lds + SHM_K, KR_lds + SHM_KR, qr, qrl, r32, hi);
  finishSM(pA0, pA1, alA, l_reg, pa0, pa1, pa2, pa3); SBAR();
  pv_d0(o, vb0, pa0, pa1, pa2, pa3); partialSM<!MLA>(pB0, pB1, m_reg, mnB, alB, C, THRR, qi, kb0 + (NT - 1) * KVBLK, hi);
  __syncthreads(); RESC(alB);
  finishSM(pB0, pB1, alB, l_reg, pa0, pa1, pa2, pa3); SBAR();
  pv_d0(o, vb0 + SHM_V, pa0, pa1, pa2, pa3);
  if (hi == 0) li_l[r32] = l_reg; asm volatile("s_waitcnt lgkmcnt(0)" ::: "memory");
  float rli[16];
#pragma unroll
  for (int r = 0; r < 16; ++r) rli[r] = __builtin_amdgcn_rcpf(li_l[crow(r, hi)]);
  bf16* Ow = Ob + (long)(wid * QBLK) * LDQ;
#pragma unroll
  for (int r = 0; r < 16; ++r) { const int orow = crow(r, hi);
#pragma unroll
    for (int d0 = 0; d0 < 4; ++d0) { const float v = o[d0][r] * rli[r]; Ow[(long)orow * LDQ + d0 * 32 + r32] = (bf16)(cvtpk(v, v) & 0xffffu); } }
  asm volatile("s_waitcnt vmcnt(0)" ::: "memory"); __syncthreads();
#undef SLOAD
#undef SWRITE
#undef SWAIT
#undef RESC
}
__device__ __forceinline__ void glds16(const void* gsrc, unsigned lds_dst) {
  unsigned keep; asm volatile("s_mov_b32 %0, m0\n\ts_mov_b32 m0, %2\n\ts_nop 0\n\tglobal_load_lds_dwordx4 %1, off\n\ts_mov_b32 m0, %0" : "=&s"(keep) : "v"(gsrc), "s"(lds_dst) : "memory"); }
template <bool MLA, int LDQ, int LDQR, int LDK>
__device__ __forceinline__ void attn_body_dma(const bf16* Qb, const bf16* Qrb, const bf16* __restrict__ Kh, const bf16* __restrict__ Vh, const bf16* __restrict__ KRh,
                                              bf16* Ob, int NT, const float C, const float THRR, const float m0, const float l0, int q0, int kb0, char* lds, const int wave_s) {
  constexpr int NR = MLA ? 4 : 0;
  int tid_ = wave_s * 64 + lane_id_fresh(); asm volatile("" : "+v"(tid_));
  const int tid = tid_, wid = tid >> 6, lane = tid & 63, r32 = lane & 31, hi = lane >> 5;
  char* V_lds = lds + O3_V; char* K_lds = lds + O3_K; char* KR_lds = lds + O3_KR;
  float* wsf = (float*)(lds + O3_WS) + wid * 64; float* li_l = wsf; float* al_l = wsf + 32;
  float m_reg = m0, l_reg = l0; f32x16 o[4] = {}; bf16x8 qr[8];
  const bf16* Qw = Qb + (long)(wid * QBLK + r32) * LDQ + hi * 8;
#pragma unroll
  for (int d0 = 0; d0 < 8; ++d0) qr[d0] = *reinterpret_cast<const bf16x8*>(Qw + d0 * 16);
  const char* qrl = lds + O3_QR + wid * 4096 + lane * 16;
  if (MLA) { const bf16* Qrw = Qrb + (long)(wid * QBLK + r32) * LDQR + hi * 8;
#pragma unroll
    for (int d0 = 0; d0 < NR; ++d0) *(bf16x8*)(lds + O3_QR + wid * 4096 + lane * 16 + d0 * 1024) = *reinterpret_cast<const bf16x8*>(Qrw + d0 * 16); }
  const int qi = q0 + wid * QBLK + r32;
  const int vb0 = (int)(uintptr_t)V_lds + v_rd_base(lane);
  unsigned offK[2], offV[2], offKR;
#pragma unroll
  for (int i = 0; i < 2; ++i) { const int B = (2 * wid + i) * 1024 + 16 * lane;
    { const int row = B >> 8, pc = (B >> 4) & 15; offK[i] = (unsigned)(row * LDK * 2 + ((pc ^ (row & 15)) << 4)); }
    { const int s_ = B >> 9, o_ = B & 511, kk = (s_ >> 2) * 8 + (o_ >> 6), c = (s_ & 3) * 32 + ((o_ & 63) >> 1), k = (kk & ~0xC) | ((kk & 4) << 1) | ((kk & 8) >> 1);
      offV[i] = (unsigned)(k * LDK * 2 + c * 2); } }
  { const int B = wid * 1024 + 16 * lane, row = B >> 7, pc = (B >> 4) & 7; offKR = (unsigned)(row * 128 + ((pc ^ ((row >> 1) & 7)) << 4)); }
  const unsigned ldsb = (unsigned)__builtin_amdgcn_readfirstlane((int)(uintptr_t)lds);
  const unsigned ldsV = ldsb + O3_V + 2 * wave_s * 1024, ldsK = ldsb + O3_K + 2 * wave_s * 1024, ldsKR = ldsb + O3_KR + wave_s * 1024;
#define DMA_TILE(t, b) do { const size_t tb_ = (size_t)(t) * (KVBLK * LDK * 2); \
    glds16((const char*)Kh + tb_ + offK[0], ldsK + (b) * SHM_K); glds16((const char*)Kh + tb_ + offK[1], ldsK + (b) * SHM_K + 1024); \
    glds16((const char*)Vh + tb_ + offV[0], ldsV + (b) * SHM_V); glds16((const char*)Vh + tb_ + offV[1], ldsV + (b) * SHM_V + 1024); \
    if (MLA) glds16((const char*)KRh + (size_t)(t) * (KVBLK * 128) + offKR, ldsKR + (b) * SHM_KR); } while (0)
#define PUBLISH() asm volatile("s_waitcnt vmcnt(0)\n\ts_barrier" ::: "memory")
#define RESC3(a) do { if (__any((a) < 1.f)) { if (hi == 0) al_l[r32] = (a); asm volatile("s_waitcnt lgkmcnt(0)" ::: "memory"); \
    _Pragma("unroll") for (int d = 0; d < 4; ++d) _Pragma("unroll") for (int r = 0; r < 16; ++r) o[d][r] *= al_l[crow(r, hi)]; } } while (0)
  f32x16 pA0, pA1, pB0, pB1; float mnA, mnB, alA, alB; bf16x8 pa0, pa1, pa2, pa3;
  DMA_TILE(0, 0); DMA_TILE(1, 1); asm volatile("s_waitcnt lgkmcnt(0)" ::: "memory"); PUBLISH();
  qkt<NR>(pA0, pA1, K_lds, KR_lds, qr, qrl, r32, hi); partialSM<!MLA>(pA0, pA1, m_reg, mnA, alA, C, THRR, qi, kb0, hi);
  int bprev = 0, bcur = 1, bnext = 2;
#define ROT3() do { const int t_ = bprev; bprev = bcur; bcur = bnext; bnext = t_; } while (0)
  for (int j = 1; j + 1 < NT; j += 2) {
    DMA_TILE(j + 1, bnext);
    SBAR(); qkt<NR>(pB0, pB1, K_lds + bcur * SHM_K, KR_lds + bcur * SHM_KR, qr, qrl, r32, hi);
    finishSM(pA0, pA1, alA, l_reg, pa0, pa1, pa2, pa3); SBAR();
    pv_d0(o, vb0 + bprev * SHM_V, pa0, pa1, pa2, pa3); partialSM<!MLA>(pB0, pB1, m_reg, mnB, alB, C, THRR, qi, kb0 + j * KVBLK, hi);
    RESC3(alB); PUBLISH(); ROT3();
    DMA_TILE(j + 2, bnext);
    SBAR(); qkt<NR>(pA0, pA1, K_lds + bcur * SHM_K, KR_lds + bcur * SHM_KR, qr, qrl, r32, hi);
    finishSM(pB0, pB1, alB, l_reg, pa0, pa1, pa2, pa3); SBAR();
    pv_d0(o, vb0 + bprev * SHM_V, pa0, pa1, pa2, pa3); partialSM<!MLA>(pA0, pA1, m_reg, mnA, alA, C, THRR, qi, kb0 + (j + 1) * KVBLK, hi);
    RESC3(alA); PUBLISH(); ROT3();
  }
  SBAR(); qkt<NR>(pB0, pB1, K_lds + bcur * SHM_K, KR_lds + bcur * SHM_KR, qr, qrl, r32, hi);
  finishSM(pA0, pA1, alA, l_reg, pa0, pa1, pa2, pa3); SBAR();
  pv_d0(o, vb0 + bprev * SHM_V, pa0, pa1, pa2, pa3); partialSM<!MLA>(pB0, pB1, m_reg, mnB, alB, C, THRR, qi, kb0 + (NT - 1) * KVBLK, hi);
  RESC3(alB);
  finishSM(pB0, pB1, alB, l_reg, pa0, pa1, pa2, pa3); SBAR();
  pv_d0(o, vb0 + bcur * SHM_V, pa0, pa1, pa2, pa3);
  if (hi == 0) li_l[r32] = l_reg; asm volatile("s_waitcnt lgkmcnt(0)" ::: "memory");
  float rli[16];
#pragma unroll
  for (int r = 0; r < 16; ++r) rli[r] = __builtin_amdgcn_rcpf(li_l[crow(r, hi)]);
  bf16* Ow = Ob + (long)(wid * QBLK) * LDQ;
#pragma unroll
  for (int r = 0; r < 16; ++r) { const int orow = crow(r, hi);
#pragma unroll
    for (int d0 = 0; d0 < 4; ++d0) { const float v = o[d0][r] * rli[r]; Ow[(long)orow * LDQ + d0 * 32 + r32] = (bf16)(cvtpk(v, v) & 0xffffu); } }
  asm volatile("s_waitcnt vmcnt(0) lgkmcnt(0)\n\ts_barrier" ::: "memory");
#undef DMA_TILE
#undef PUBLISH
#undef RESC3
#undef ROT3
}
template <int NR> __device__ __forceinline__ void qkt_r(f32x16& p0, f32x16& p1, const char* Ks, const char* KRs, const bf16x8* qr, int r32, int hi) {
  p0 = f32x16{}; p1 = f32x16{};
#pragma unroll
  for (int d0 = 0; d0 < 8; ++d0) { const int cb = (d0 * 16 + hi * 8) * 2;
    const bf16x8 b0 = *reinterpret_cast<const bf16x8*>(Ks + KSWZ(r32, cb)); const bf16x8 b1 = *reinterpret_cast<const bf16x8*>(Ks + KSWZ(32 + r32, cb));
    p0 = __builtin_amdgcn_mfma_f32_32x32x16_bf16(b0, qr[d0], p0, 0, 0, 0); p1 = __builtin_amdgcn_mfma_f32_32x32x16_bf16(b1, qr[d0], p1, 0, 0, 0); }
#pragma unroll
  for (int d0 = 0; d0 < NR; ++d0) { const int cb = (d0 * 16 + hi * 8) * 2;
    const bf16x8 b0 = *reinterpret_cast<const bf16x8*>(KRs + KRSWZ(r32, cb)); const bf16x8 b1 = *reinterpret_cast<const bf16x8*>(KRs + KRSWZ(32 + r32, cb));
    p0 = __builtin_amdgcn_mfma_f32_32x32x16_bf16(b0, qr[8 + d0], p0, 0, 0, 0); p1 = __builtin_amdgcn_mfma_f32_32x32x16_bf16(b1, qr[8 + d0], p1, 0, 0, 0); }
}
template <bool MLA, int LDQ, int LDQR, int LDK>
__device__ __forceinline__ void attn_body_stg(const bf16* Qb, const bf16* Qrb, const bf16* __restrict__ Kh, const bf16* __restrict__ Vh, const bf16* __restrict__ KRh,
                                              bf16* Ob, int NT, const float C, const float THRR, const float m0, const float l0, int q0, int kb0, char* lds, const int wave_s) {
  constexpr int NR = MLA ? 4 : 0;
  int tid_ = wave_s * 64 + lane_id_fresh(); asm volatile("" : "+v"(tid_));
  const int tid = tid_, wid = tid >> 6, lane = tid & 63, r32 = lane & 31, hi = lane >> 5;
  const bool late = wave_s >= 4;
  char* V_lds = lds + S4_V; char* K_lds = lds + S4_K; char* KR_lds = lds + S4_KR;
  float* wsf = (float*)(lds + S4_WS) + wid * 64; float* li_l = wsf; float* al_l = wsf + 32;
  float m_reg = m0, l_reg = l0; f32x16 o[4] = {}; bf16x8 qr[8 + NR];
  const bf16* Qw = Qb + (long)(wid * QBLK + r32) * LDQ + hi * 8;
#pragma unroll
  for (int d0 = 0; d0 < 8; ++d0) qr[d0] = *reinterpret_cast<const bf16x8*>(Qw + d0 * 16);
  if (MLA) { const bf16* Qrw = Qrb + (long)(wid * QBLK + r32) * LDQR + hi * 8;
#pragma unroll
    for (int d0 = 0; d0 < NR; ++d0) qr[8 + d0] = *reinterpret_cast<const bf16x8*>(Qrw + d0 * 16); }
  const int qi = q0 + wid * QBLK + r32;
  const int vb0 = (int)(uintptr_t)V_lds + v_rd_base(lane);
  unsigned offK[2], offV[2], offKR;
#pragma unroll
  for (int i = 0; i < 2; ++i) { const int B = (2 * wid + i) * 1024 + 16 * lane;
    { const int row = B >> 8, pc = (B >> 4) & 15; offK[i] = (unsigned)(row * LDK * 2 + ((pc ^ (row & 15)) << 4)); }
    { const int s_ = B >> 9, o_ = B & 511, kk = (s_ >> 2) * 8 + (o_ >> 6), c = (s_ & 3) * 32 + ((o_ & 63) >> 1), k = (kk & ~0xC) | ((kk & 4) << 1) | ((kk & 8) >> 1);
      offV[i] = (unsigned)(k * LDK * 2 + c * 2); } }
  { const int B = wid * 1024 + 16 * lane, row = B >> 7, pc = (B >> 4) & 7; offKR = (unsigned)(row * 128 + ((pc ^ ((row >> 1) & 7)) << 4)); }
  const unsigned ldsb = (unsigned)__builtin_amdgcn_readfirstlane((int)(uintptr_t)lds);
  const unsigned ldsV = ldsb + S4_V + 2 * wave_s * 1024, ldsK = ldsb + S4_K + 2 * wave_s * 1024, ldsKR = ldsb + S4_KR + wave_s * 1024;
#define DMA_T(t, kb_, vb_) do { const size_t tb_ = (size_t)(t) * (KVBLK * LDK * 2); \
    glds16((const char*)Kh + tb_ + offK[0], ldsK + (kb_) * SHM_K); glds16((const char*)Kh + tb_ + offK[1], ldsK + (kb_) * SHM_K + 1024); \
    glds16((const char*)Vh + tb_ + offV[0], ldsV + (vb_) * SHM_V); glds16((const char*)Vh + tb_ + offV[1], ldsV + (vb_) * SHM_V + 1024); \
    if (MLA) glds16((const char*)KRh + (size_t)(t) * (KVBLK * 128) + offKR, ldsKR + (kb_) * SHM_KR); } while (0)
#define PUBLISH() asm volatile("s_waitcnt vmcnt(0)\n\ts_barrier" ::: "memory")
#define RESC3(a) do { if (__any((a) < 1.f)) { if (hi == 0) al_l[r32] = (a); asm volatile("s_waitcnt lgkmcnt(0)" ::: "memory"); \
    _Pragma("unroll") for (int d = 0; d < 4; ++d) _Pragma("unroll") for (int r = 0; r < 16; ++r) o[d][r] *= al_l[crow(r, hi)]; } } while (0)
  int kd = 2, vd = 2;
#define AFTER_BAR(k) do { if ((k) + 2 < NT) { DMA_T((k) + 2, kd, vd); } kd = (kd == 2) ? 0 : kd + 1; vd = (vd + 1) & 3; } while (0)
  f32x16 pA0, pA1, pB0, pB1; float mnA, mnB, alA, alB; bf16x8 pa0, pa1, pa2, pa3;
  DMA_T(0, 0, 0); DMA_T(1, 1, 1); PUBLISH();
  AFTER_BAR(0);
  qkt_r<NR>(pA0, pA1, K_lds, KR_lds, qr, r32, hi); partialSM<!MLA>(pA0, pA1, m_reg, mnA, alA, C, THRR, qi, kb0, hi);
  int kc = 1, vp = 0;
  for (int j = 1; j + 1 < NT; j += 2) {
    SBAR(); qkt_r<NR>(pB0, pB1, K_lds + kc * SHM_K, KR_lds + kc * SHM_KR, qr, r32, hi);
    finishSM(pA0, pA1, alA, l_reg, pa0, pa1, pa2, pa3); SBAR();
    if (late) { PUBLISH(); AFTER_BAR(j); }
    pv_d0(o, vb0 + vp * SHM_V, pa0, pa1, pa2, pa3); partialSM<!MLA>(pB0, pB1, m_reg, mnB, alB, C, THRR, qi, kb0 + j * KVBLK, hi);
    RESC3(alB);
    if (!late) { PUBLISH(); AFTER_BAR(j); }
    kc = (kc == 2) ? 0 : kc + 1; vp = (vp + 1) & 3;
    SBAR(); qkt_r<NR>(pA0, pA1, K_lds + kc * SHM_K, KR_lds + kc * SHM_KR, qr, r32, hi);
    finishSM(pB0, pB1, alB, l_reg, pa0, pa1, pa2, pa3); SBAR();
    if (late) { PUBLISH(); AFTER_BAR(j + 1); }
    pv_d0(o, vb0 + vp * SHM_V, pa0, pa1, pa2, pa3); partialSM<!MLA>(pA0, pA1, m_reg, mnA, alA, C, THRR, qi, kb0 + (j + 1) * KVBLK, hi);
    RESC3(alA);
    if (!late) { PUBLISH(); AFTER_BAR(j + 1); }
    kc = (kc == 2) ? 0 : kc + 1; vp = (vp + 1) & 3;
  }
  SBAR(); qkt_r<NR>(pB0, pB1, K_lds + kc * SHM_K, KR_lds + kc * SHM_KR, qr, r32, hi);
  finishSM(pA0, pA1, alA, l_reg, pa0, pa1, pa2, pa3); SBAR();
  if (late) { PUBLISH(); }
  pv_d0(o, vb0 + vp * SHM_V, pa0, pa1, pa2, pa3); partialSM<!MLA>(pB0, pB1, m_reg, mnB, alB, C, THRR, qi, kb0 + (NT - 1) * KVBLK, hi);
  RESC3(alB);
  if (!late) { PUBLISH(); }
  vp = (vp + 1) & 3;
  finishSM(pB0, pB1, alB, l_reg, pa0, pa1, pa2, pa3); SBAR();
  pv_d0(o, vb0 + vp * SHM_V, pa0, pa1, pa2, pa3);
  if (hi == 0) li_l[r32] = l_reg; asm volatile("s_waitcnt lgkmcnt(0)" ::: "memory");
  float rli[16];
#pragma unroll
  for (int r = 0; r < 16; ++r) rli[r] = __builtin_amdgcn_rcpf(li_l[crow(r, hi)]);
  bf16* Ow = Ob + (long)(wid * QBLK) * LDQ;
#pragma unroll
  for (int r = 0; r < 16; ++r) { const int orow = crow(r, hi);
#pragma unroll
    for (int d0 = 0; d0 < 4; ++d0) { const float v = o[d0][r] * rli[r]; Ow[(long)orow * LDQ + d0 * 32 + r32] = (bf16)(cvtpk(v, v) & 0xffffu); } }
  asm volatile("s_waitcnt vmcnt(0) lgkmcnt(0)\n\ts_barrier" ::: "memory");
#undef DMA_T
#undef PUBLISH
#undef RESC3
#undef AFTER_BAR
}
#undef KSWZ
#undef KRSWZ
#undef SBAR
}
constexpr int NWAVES = 8;
constexpr int NB = 8, SEQ = 4096, M = NB * SEQ, D = 2048, FF = 5632, DEPTH = 2, NMOD = 9 * D, WIN_SRC = 6720, WIN_N = 6912;
constexpr float EPS = 1e-6f;
constexpr size_t MiB = 1u << 20;
constexpr size_t WS_CTL = 0, WS_MOD = 1 * MiB, WS_SS = 2 * MiB + 256 * 1024  , WS_ZERO_BYTES = 3 * MiB;
constexpr size_t WS_COSA = 4 * MiB, WS_SINA = 12 * MiB, WS_COSR = 20 * MiB, WS_SINR = 24 * MiB;
constexpr size_t WS_W = 28 * MiB;
constexpr size_t LW_GU1 = 0, LW_D1 = LW_GU1 + (size_t)2 * FF * D, LW_GU2 = LW_D1 + (size_t)FF * D, LW_D2 = LW_GU2 + (size_t)2 * FF * D, LW_IN = LW_D2 + (size_t)FF * D,
                 LW_UQ = LW_IN + (size_t)WIN_N * D, LW_UKV = LW_UQ + (size_t)1536 * 512, LW_OA = LW_UKV + (size_t)2048 * 512, LW_OB = LW_OA + (size_t)2048 * 1024,
                 LW_OUT = LW_OB + (size_t)2048 * 1024, LW_ELEMS = LW_OUT + (size_t)2048 * 2048;
static_assert(LW_ELEMS == 93585408, "weight map");
constexpr size_t WS_X16 = WS_W + ((2 * LW_ELEMS * 2 + MiB - 1) / MiB) * MiB;
constexpr size_t WS_BIG = WS_X16 + 128 * MiB;
constexpr size_t B_QA = 0  ,
                 B_KA = 128 * MiB, B_VA = 144 * MiB, B_CQN = 160 * MiB, B_CKVN = 192 * MiB, B_KR = 224 * MiB, B_GATES = 232 * MiB, B_QBR = 488 * MiB, B_KVB = 520 * MiB, B_END = 648 * MiB;
constexpr size_t B_ACT = 0, B_DELTA = 352 * MiB  ;
constexpr size_t WS_END = WS_BIG + B_END;
static_assert((size_t)M * FF * 2 <= B_END && WS_X16 == 385 * MiB, "d_ws map");
constexpr int CW_BAR = 4096;
constexpr int LDS_BYTES = 163840, LDSCTL_OFF = 162816, SCR_OFF = 65536, SCR_WAVE = 8448;
static_assert(SCR_OFF + NWAVES * SCR_WAVE <= LDSCTL_OFF && att::ATT_LDS <= 131072 && att::ATT3_LDS <= LDSCTL_OFF, "LDS map");

#define GAS __attribute__((address_space(1)))
#define LAS __attribute__((address_space(3)))
typedef unsigned short bf16;
typedef unsigned v4u __attribute__((ext_vector_type(4)));
typedef unsigned v2u __attribute__((ext_vector_type(2)));
typedef float f32x4 __attribute__((ext_vector_type(4)));
typedef _Float16 h16x4 __attribute__((ext_vector_type(4)));
#define LDS_WAIT() asm volatile("s_waitcnt lgkmcnt(0)" ::: "memory")
#define VM_WAIT() asm volatile("s_waitcnt vmcnt(0)" ::: "memory")
__device__ __forceinline__ unsigned f2bf(float f) { unsigned u = __builtin_bit_cast(unsigned, f); return (u + 0x7fffu + ((u >> 16) & 1u)) >> 16; }
__device__ __forceinline__ unsigned pk2(float lo, float hi) { return f2bf(lo) | (f2bf(hi) << 16); }
template <int CTRL> __device__ __forceinline__ float dpp_add(float v) { return v + __int_as_float(__builtin_amdgcn_update_dpp(0, __float_as_int(v), CTRL, 0xf, 0xf, true)); }
__device__ __forceinline__ float wave_sum(float v) {
    v = dpp_add<0xB1>(v);
    v = dpp_add<0x4E>(v);
    v = dpp_add<0x141>(v);
    v = dpp_add<0x140>(v);
    { auto r = __builtin_amdgcn_permlane16_swap(__float_as_uint(v), __float_as_uint(v), false, false); v = __uint_as_float(r[0]) + __uint_as_float(r[1]); }
    { auto r = __builtin_amdgcn_permlane32_swap(__float_as_uint(v), __float_as_uint(v), false, false); v = __uint_as_float(r[0]) + __uint_as_float(r[1]); }
    return v;
}
#define XB_TMO      128
#define XB_XCNT(j)  (256  + 64 * (j))
#define XB_XSUB(j)  (1280 + 64 * (j))
#define XB_XGEN(j)  (2304 + 64 * (j))
#define XB_TOP      3328
#define XB_TOPGEN   3392
#define XCD_BAR_WORDS 3456
#define XB_SPIN_CAP (1u << 18)

__device__ __forceinline__ unsigned xb_ld(unsigned* p)              { return __hip_atomic_load(p, __ATOMIC_RELAXED, __HIP_MEMORY_SCOPE_AGENT); }
__device__ __forceinline__ unsigned xb_add(unsigned* p, unsigned v) { return __hip_atomic_fetch_add(p, v, __ATOMIC_RELAXED, __HIP_MEMORY_SCOPE_AGENT); }
__device__ __forceinline__ unsigned xb_xcc_id() { return (unsigned)__builtin_amdgcn_s_getreg((3 << 11) | 20) & 0xFu; }
#define XB_SPIN(cond, bar) do { unsigned _sp = 0; while (cond) { __builtin_amdgcn_s_sleep(1); \
    if ((++_sp & 255u) == 0u) { if (xb_ld(&(bar)[XB_TMO])) break; if (_sp > XB_SPIN_CAP) { atomicAdd(&(bar)[XB_TMO], 1u); break; } } } } while (0)

struct XcdBarrier {
    unsigned* bar; unsigned x;
    unsigned wv;
    volatile LAS unsigned* st;
};

__device__ __forceinline__ XcdBarrier xcd_barrier_post(unsigned* bar, volatile LAS unsigned* st) {
    XcdBarrier b; b.bar = bar; b.x = xb_xcc_id(); b.st = st; b.wv = (unsigned)__builtin_amdgcn_readfirstlane(threadIdx.x >> 6);
    if (threadIdx.x == 0) (void)xb_add(&bar[XB_XCNT(b.x)], 1u);
    return b;
}
__device__ __forceinline__ void xcd_barrier_complete(unsigned* bar, unsigned x, unsigned& nloc, unsigned& nx) {
    const unsigned G = gridDim.x * gridDim.y * gridDim.z;
    unsigned sum, cnt, mine, sp = 0u;
    for (;;) {
        sum = 0u; cnt = 0u; mine = 0u;
#pragma unroll
        for (unsigned j = 0; j < 16; ++j) { const unsigned c = xb_ld(&bar[XB_XCNT(j)]); sum += c; cnt += (c > 0u) ? 1u : 0u; mine = (j == x) ? c : mine; }
        if (sum == G) break;
        __builtin_amdgcn_s_sleep(1);
        if ((++sp & 255u) == 0u) { if (xb_ld(&bar[XB_TMO])) break; if (sp > XB_SPIN_CAP) { atomicAdd(&bar[XB_TMO], 1u); break; } }
    }
    nloc = mine > 0u ? mine : 1u; nx = cnt > 0u ? cnt : 1u;
}

__device__ __forceinline__ void xcd_barrier(const XcdBarrier& b) {
    asm volatile("s_waitcnt vmcnt(0)" ::: "memory");
    __syncthreads();
    if (b.wv == 0u && lane_id_fresh() == 0) {
        unsigned* bar = b.bar;
        __builtin_amdgcn_s_waitcnt(0);
        unsigned nloc = b.st[0], nx = b.st[1];
        if (nloc == 0u) { xcd_barrier_complete(bar, b.x, nloc, nx); b.st[0] = nloc; b.st[1] = nx; }
        const unsigned old = xb_add(&bar[XB_XSUB(b.x)], 1u);
        const unsigned gen = old / nloc;
        if (old + 1u == (gen + 1u) * nloc) {
            __builtin_amdgcn_fence(__ATOMIC_RELEASE, "agent");
            asm volatile("s_waitcnt vmcnt(0)" ::: "memory");
            const unsigned og = xb_add(&bar[XB_TOP], 1u);
            const unsigned tg = og / nx;
            if (og + 1u == (tg + 1u) * nx) xb_add(&bar[XB_TOPGEN], 1u);
            else XB_SPIN(xb_ld(&bar[XB_TOPGEN]) == tg, bar);
            __builtin_amdgcn_fence(__ATOMIC_ACQUIRE, "agent");
            xb_add(&bar[XB_XGEN(b.x)], 1u);
            asm volatile("s_waitcnt vmcnt(0)" ::: "memory");
        } else {
            XB_SPIN(xb_ld(&bar[XB_XGEN(b.x)]) == gen, bar);
            __builtin_amdgcn_fence(__ATOMIC_ACQUIRE, "agent");
            asm volatile("s_waitcnt vmcnt(0)" ::: "memory");
        }
    }
    __syncthreads();
}
#define LOCAL_IDS() int tid_ = wave_s * 64 + lane_id_fresh(); asm volatile("" : "+v"(tid_)); const int lane = tid_ & 63, gw = vcu * NWAVES + __builtin_amdgcn_readfirstlane(tid_ >> 6), NGW = G * NWAVES
__device__ __forceinline__ int map_col(int map, int n) {
    if (map == 0) return n;
    if (map == 1) { const int t = n >> 8, j = n & 255; return j < 128 ? 128 * t + j : FF + 128 * t + (j - 128); }
    if (map == 2) {
        const int t = n >> 8, j = n & 255, bj = j >> 7, jj = j & 127;
        if (t < 4) return (2 * t + (jj >> 6)) * 128 + (jj & 63) + 64 * bj;
        if (t == 4) return 1024 + (jj >> 6) * 128 + (jj & 63) + 64 * bj;
        if (t == 5) return 1280 + j;
        if (t < 10) return 1536 + (t - 6) * 256 + j;
        if (t == 10) return jj < 32 ? 2560 + bj * 32 + jj : -1;
        return 2624 + (t - 11) * 256 + j;
    }
    {
        if (n < 1024) return (n >> 7) * 192 + (n & 127);
        const int t = (n >> 8) - 4, j = n & 255, bj = j >> 7, jj = j & 127;
        return (4 * t + (jj >> 5)) * 192 + 128 + (jj & 31) + 32 * bj;
    }
}
__device__ __forceinline__ void tr_item(const float* W, int K, int Nsrc, int Ndst, bf16* WT, int map, LAS float* scr, int item, int lane, int ldt = 0) {
    const int nblk = Ndst >> 5, kb = item / nblk, nb = item - kb * nblk, k0 = 64 * kb, n0 = 32 * nb;
    const int src = map_col(map, n0 + (lane & 31));
    const float* wp = W + (size_t)(k0 + (lane >> 5)) * Nsrc + (src < 0 ? 0 : src);
    float tv[32];
#pragma unroll
    for (int i = 0; i < 32; ++i) tv[i] = wp[(size_t)(2 * i) * Nsrc];
#pragma unroll
    for (int i = 0; i < 32; ++i) scr[(2 * i + (lane >> 5)) * 33 + (lane & 31)] = src < 0 ? 0.f : tv[i];
    LDS_WAIT(); asm volatile("" ::: "memory");
    const int c = lane & 7;
#pragma unroll
    for (int j = 0; j < 4; ++j) { const int n = (lane >> 3) + 8 * j; const LAS float* s = scr + (8 * c) * 33 + n;
        v4u o; o.x = pk2(s[0 * 33], s[1 * 33]); o.y = pk2(s[2 * 33], s[3 * 33]); o.z = pk2(s[4 * 33], s[5 * 33]); o.w = pk2(s[6 * 33], s[7 * 33]);
        *(v4u*)(WT + (size_t)(n0 + n) * (ldt ? ldt : K) + k0 + 8 * c) = o; }
    LDS_WAIT(); asm volatile("" ::: "memory");
}
__device__ __forceinline__ void sincos_d(float angf, float& s_out, float& c_out) {
    const double a = (double)angf;
    const double q = __builtin_rint(a * 0.63661977236758134308);
    double t = __builtin_fma(-q, 1.57079632679489655800, a); t = __builtin_fma(-q, 6.12323399573676603587e-17, t);
    const double t2 = t * t;
    double sp = 1.0 / 6227020800.0; sp = sp * t2 - 1.0 / 39916800.0; sp = sp * t2 + 1.0 / 362880.0; sp = sp * t2 - 1.0 / 5040.0; sp = sp * t2 + 1.0 / 120.0; sp = sp * t2 - 1.0 / 6.0; sp = sp * t2 + 1.0; sp = sp * t;
    double cp = -1.0 / 87178291200.0; cp = cp * t2 + 1.0 / 479001600.0; cp = cp * t2 - 1.0 / 3628800.0; cp = cp * t2 + 1.0 / 40320.0; cp = cp * t2 - 1.0 / 720.0; cp = cp * t2 + 1.0 / 24.0; cp = cp * t2 - 0.5; cp = cp * t2 + 1.0;
    const int qi = ((int)(long long)q) & 3;
    const double s = (qi == 0) ? sp : (qi == 1) ? cp : (qi == 2) ? -sp : -cp;
    const double c = (qi == 0) ? cp : (qi == 1) ? -sp : (qi == 2) ? -cp : sp;
    s_out = (float)s; c_out = (float)c;
}

struct P {
    const float *x, *c, *norm_g, *w_ada, *b_ada, *w_gu1, *w_d1, *w_gu2, *w_d2, *w_in, *b_gate, *sink, *g_cq, *g_ckv, *w_uq, *w_ukv, *w_oa, *w_ob, *w_out, *g_final;
    const int* pos; float* out; unsigned char* ws;
};

__device__ __forceinline__ void prologue(const P& p, LAS unsigned char* lds, int vcu, int G, const bool skip_ada, const int wave_s) {
    LOCAL_IDS(); const int tid = tid_, wave = __builtin_amdgcn_readfirstlane(tid_ >> 6);
    LAS float* cact = (LAS float*)lds;
    for (int i = tid; i < NB * D; i += NWAVES * 64) { const int b = i >> 11, k = i & 2047; const float cv = p.c[i]; cact[k * 8 + b] = cv / (1.0f + expf(-cv)); }
    __syncthreads();
    LAS float* scr = (LAS float*)(lds + SCR_OFF + wave * SCR_WAVE);
    float* mod = (float*)(p.ws + WS_MOD);
    constexpr int I_ADA = DEPTH * 72 * 8, I_TAB = M / 16;
    constexpr int I_GU = 32 * 352, I_D = 88 * 64, I_IN = 32 * (WIN_N / 32), I_UQ = 8 * 48, I_UKV = 8 * 64, I_O = 16 * 64, I_OUT = 32 * 64;
    constexpr int I_LAYER = 2 * I_GU + 2 * I_D + I_IN + I_UQ + I_UKV + 2 * I_O + I_OUT;
    constexpr int NITEMS = I_ADA + I_TAB + DEPTH * I_LAYER;
    for (int it = gw; it < NITEMS; it += NGW) {
        int r = it;
        if (r < I_ADA) { if (skip_ada) continue;
            const int l = r / 576, rr = r - l * 576, cg = rr >> 3, kc = rr & 7;
            const float* W = p.w_ada + ((size_t)l * D + 256 * kc) * NMOD + 256 * cg + 4 * lane;
            f32x4 acc[8];
#pragma unroll
            for (int b = 0; b < 8; ++b) acc[b] = (f32x4){0.f, 0.f, 0.f, 0.f};
            for (int k = 0; k < 256; k += 16) {
                f32x4 w[16];
#pragma unroll
                for (int kk = 0; kk < 16; ++kk) w[kk] = *(const f32x4*)(W + (size_t)(k + kk) * NMOD);
#pragma unroll
                for (int kk = 0; kk < 16; ++kk) { const LAS f32x4* cp = (const LAS f32x4*)(cact + (256 * kc + k + kk) * 8); const f32x4 c0 = cp[0], c1 = cp[1];
                    acc[0] += w[kk] * c0[0]; acc[1] += w[kk] * c0[1]; acc[2] += w[kk] * c0[2]; acc[3] += w[kk] * c0[3];
                    acc[4] += w[kk] * c1[0]; acc[5] += w[kk] * c1[1]; acc[6] += w[kk] * c1[2]; acc[7] += w[kk] * c1[3]; }
            }
            if (kc == 0) { const f32x4 bv = *(const f32x4*)(p.b_ada + (size_t)l * NMOD + 256 * cg + 4 * lane);
#pragma unroll
                for (int b = 0; b < 8; ++b) acc[b] += bv; }
#pragma unroll
            for (int b = 0; b < 8; ++b) { float* dst = mod + (size_t)(l * 8 + b) * NMOD + 256 * cg + 4 * lane;
#pragma unroll
                for (int i = 0; i < 4; ++i) unsafeAtomicAdd(dst + i, acc[b][i]); }
            continue;
        }
        r -= I_ADA;
        if (r < I_TAB) {
            const double ea = -(double)lane * (1.0 / 64.0), er = -(double)(lane & 31) * (1.0 / 32.0);
            const float fa = (float)exp2(ea * 13.287712379549449), fr = (float)exp2(er * 13.287712379549449);
            float* cosA = (float*)(p.ws + WS_COSA); float* sinA = (float*)(p.ws + WS_SINA); float* cosR = (float*)(p.ws + WS_COSR); float* sinR = (float*)(p.ws + WS_SINR);
            for (int i = 0; i < 16; ++i) { const int m = 16 * r + i; const float pf = (float)p.pos[m];
                float s, c; sincos_d(pf * fa, s, c); cosA[(size_t)m * 64 + lane] = c; sinA[(size_t)m * 64 + lane] = s;
                if (lane < 32) { sincos_d(pf * fr, s, c); cosR[(size_t)m * 32 + lane] = c; sinR[(size_t)m * 32 + lane] = s; } }
            continue;
        }
        r -= I_TAB;
        const int l = r >= I_LAYER ? 1 : 0; r -= l * I_LAYER;
        bf16* wl = (bf16*)(p.ws + WS_W) + (size_t)l * LW_ELEMS;
        if (r < I_GU) { tr_item(p.w_gu1 + (size_t)l * D * 2 * FF, D, 2 * FF, 2 * FF, wl + LW_GU1, 1, scr, r, lane); continue; } r -= I_GU;
        if (r < I_D)  { tr_item(p.w_d1 + (size_t)l * FF * D, FF, D, D, wl + LW_D1, 0, scr, r, lane); continue; } r -= I_D;
        if (r < I_GU) { tr_item(p.w_gu2 + (size_t)l * D * 2 * FF, D, 2 * FF, 2 * FF, wl + LW_GU2, 1, scr, r, lane); continue; } r -= I_GU;
        if (r < I_D)  { tr_item(p.w_d2 + (size_t)l * FF * D, FF, D, D, wl + LW_D2, 0, scr, r, lane); continue; } r -= I_D;
        if (r < I_IN) { tr_item(p.w_in + (size_t)l * D * WIN_SRC, D, WIN_SRC, WIN_N, wl + LW_IN, 2, scr, r, lane); continue; } r -= I_IN;
        if (r < I_UQ) { tr_item(p.w_uq + (size_t)l * 512 * 1536, 512, 1536, 1536, wl + LW_UQ, 3, scr, r, lane); continue; } r -= I_UQ;
        if (r < I_UKV) { tr_item(p.w_ukv + (size_t)l * 512 * 2048, 512, 2048, 2048, wl + LW_UKV, 0, scr, r, lane); continue; } r -= I_UKV;
        if (r < I_O)  { tr_item(p.w_oa + (size_t)l * 1024 * 2048, 1024, 2048, 2048, wl + LW_OA, 0, scr, r, lane, 2048); continue; } r -= I_O;
        if (r < I_O)  { tr_item(p.w_ob + (size_t)l * 1024 * 2048, 1024, 2048, 2048, wl + LW_OA + 1024, 0, scr, r, lane, 2048); continue; } r -= I_O;
        tr_item(p.w_out + (size_t)l * 2048 * 2048, 2048, 2048, 2048, wl + LW_OUT, 0, scr, r, lane);
    }
}

template <bool DELTA, bool FINAL, bool XI16 = false, bool XO16 = false>
__device__ __forceinline__ void thin_phase(const void* xin_, void* xout_, const bf16* delta, const float* gate, float coef, const float* g, const float* sh, const float* sc, bf16* H, int vcu, int G, const int wave_s) {
    LOCAL_IDS();
    unsigned lo16 = (unsigned)lane * 16u, lo8 = (unsigned)lane * 8u;
#define LD16(base, j) (*(const f32x4*)((const char*)(base) + lo16 + (unsigned)(j) * 1024u))
#define ST16(base, j, v) (*(f32x4*)((char*)(base) + lo16 + (unsigned)(j) * 1024u) = (v))
#define LD8(base, j) (*(const v2u*)((const char*)(base) + lo8 + (unsigned)(j) * 512u))
#define ST8(base, j, v) (*(v2u*)((char*)(base) + lo8 + (unsigned)(j) * 512u) = (v))
    for (int blk = gw; blk < M / 16; blk += NGW) {
        const int row0 = blk * 16, b = row0 >> 12;
        const float* scb = sc + (size_t)b * NMOD; const float* shb = sh + (size_t)b * NMOD; const float* gtb = gate + (size_t)b * NMOD;
        f32x4 ca[8], cs[8], cg[8];
#pragma unroll
        for (int j = 0; j < 8; ++j) { const f32x4 gv = LD16(g, j);
            if (FINAL) { ca[j] = gv; cs[j] = (f32x4){0.f, 0.f, 0.f, 0.f}; }
            else { ca[j] = gv * (LD16(scb, j) + 1.0f); cs[j] = LD16(shb, j); }
            if (DELTA) cg[j] = LD16(gtb, j) * coef; }
        for (int i = 0; i < 16; i += 2) {
            asm volatile("" : "+v"(lo16), "+v"(lo8));
            const size_t r0 = (size_t)(row0 + i) * D;
            f32x4 v0[8], v1[8]; float ss0 = 0.f, ss1 = 0.f;
            if (XI16) { const _Float16* x0 = (const _Float16*)xin_ + r0; const _Float16* x1 = x0 + D; v2u a0[8], a1[8];
#pragma unroll
                for (int j = 0; j < 8; ++j) { a0[j] = LD8(x0, j); a1[j] = LD8(x1, j); }
#pragma unroll
                for (int j = 0; j < 8; ++j) { v0[j] = __builtin_convertvector(__builtin_bit_cast(h16x4, a0[j]), f32x4); v1[j] = __builtin_convertvector(__builtin_bit_cast(h16x4, a1[j]), f32x4); } }
            else { const float* x0 = (const float*)xin_ + r0; const float* x1 = x0 + D;
#pragma unroll
                for (int j = 0; j < 8; ++j) { v0[j] = LD16(x0, j); v1[j] = LD16(x1, j); } }
            if (DELTA) { const bf16* dl0 = delta + r0; const bf16* dl1 = dl0 + D; v2u d0[8], d1[8];
#pragma unroll
                for (int j = 0; j < 8; ++j) { d0[j] = LD8(dl0, j); d1[j] = LD8(dl1, j); }
#pragma unroll
                for (int j = 0; j < 8; ++j) {
                    v0[j] = v0[j] + cg[j] * (f32x4){__uint_as_float(d0[j].x << 16), __uint_as_float(d0[j].x & 0xffff0000u), __uint_as_float(d0[j].y << 16), __uint_as_float(d0[j].y & 0xffff0000u)};
                    v1[j] = v1[j] + cg[j] * (f32x4){__uint_as_float(d1[j].x << 16), __uint_as_float(d1[j].x & 0xffff0000u), __uint_as_float(d1[j].y << 16), __uint_as_float(d1[j].y & 0xffff0000u)}; }
                if (!FINAL && XO16) { _Float16* xo0 = (_Float16*)xout_ + r0; _Float16* xo1 = xo0 + D;
#pragma unroll
                    for (int j = 0; j < 8; ++j) { ST8(xo0, j, __builtin_bit_cast(v2u, __builtin_convertvector(v0[j], h16x4))); ST8(xo1, j, __builtin_bit_cast(v2u, __builtin_convertvector(v1[j], h16x4))); } }
                if (!FINAL && !XO16) { float* xo0 = (float*)xout_ + r0; float* xo1 = xo0 + D;
#pragma unroll
                    for (int j = 0; j < 8; ++j) { ST16(xo0, j, v0[j]); ST16(xo1, j, v1[j]); } } }
#pragma unroll
            for (int j = 0; j < 8; ++j) { ss0 += (v0[j].x * v0[j].x + v0[j].y * v0[j].y) + (v0[j].z * v0[j].z + v0[j].w * v0[j].w); ss1 += (v1[j].x * v1[j].x + v1[j].y * v1[j].y) + (v1[j].z * v1[j].z + v1[j].w * v1[j].w); }
            const float rstd0 = 1.0f / sqrtf(wave_sum(ss0) * (1.0f / D) + EPS), rstd1 = 1.0f / sqrtf(wave_sum(ss1) * (1.0f / D) + EPS);
            if (FINAL) { float* xo0 = (float*)xout_ + r0; float* xo1 = xo0 + D;
#pragma unroll
                for (int j = 0; j < 8; ++j) { ST16(xo0, j, v0[j] * rstd0 * ca[j]); ST16(xo1, j, v1[j] * rstd1 * ca[j]); } }
            else { bf16* h0p = H + r0; bf16* h1p = h0p + D;
#pragma unroll
                for (int j = 0; j < 8; ++j) { const f32x4 h0 = v0[j] * rstd0 * ca[j] + cs[j], h1 = v1[j] * rstd1 * ca[j] + cs[j]; v2u w0, w1; w0.x = pk2(h0.x, h0.y); w0.y = pk2(h0.z, h0.w); w1.x = pk2(h1.x, h1.y); w1.y = pk2(h1.z, h1.w); ST8(h0p, j, w0); ST8(h1p, j, w1); } }
        }
    }
#undef LD16
#undef ST16
#undef LD8
#undef ST8
}
#ifndef REP_NORM
#define REP_NORM 0
#endif
#ifndef REP_GU
#define REP_GU 0
#endif
#ifndef REP_D
#define REP_D 0
#endif
#ifndef REP_WIN
#define REP_WIN 0
#endif
#ifndef GU_NULL
#define GU_NULL 0
#endif
#ifndef REP_MLA
#define REP_MLA 0
#endif
#ifndef REP_SWA
#define REP_SWA 0
#endif
#ifndef REP_UQ
#define REP_UQ 0
#endif
#ifndef REP_OAB
#define REP_OAB 0
#endif
#ifndef REP_WOUT
#define REP_WOUT 0
#endif
#ifndef REP_PRO
#define REP_PRO 0
#endif
#ifndef ATTD
#define ATTD 3
#endif
#if ATTD & 1
#define ATT_MLA_BODY att::attn_body_dma<true, 2048, 512, 2048>
#else
#define ATT_MLA_BODY att::attn_body<true, 2048, 512, 2048, MLA_SD>
#endif
#if ATTD & 2
#define ATT_SWA_BODY att::attn_body_dma<false, 2048, 512, 256>
#else
#define ATT_SWA_BODY att::attn_body<false, 2048, 512, 256, WIN_SD>
#endif
#ifndef MLA_SD
#define MLA_SD 1
#endif
#ifndef WIN_SD
#define WIN_SD 2
#endif
#ifndef EN_PRO
#define EN_PRO 1
#endif
#ifndef EN_ATT
#define EN_ATT 1
#endif
#ifndef EN_G1
#define EN_G1 1
#endif
#ifndef EN_G2
#define EN_G2 1
#endif
#ifndef EN_G4
#define EN_G4 1
#endif
#ifndef EN_G6
#define EN_G6 1
#endif
#ifndef EN_G8
#define EN_G8 1
#endif
#ifndef EN_G9
#define EN_G9 1
#endif
#ifndef EN_G11
#define EN_G11 1
#endif
#ifndef EN_G12
#define EN_G12 1
#endif
struct Args { const void* in[21]; float* out; unsigned char* ws; int ph_lo, ph_hi; };
#ifndef ALIGN_WIN
#define ALIGN_WIN true
#endif
#ifndef GEMM_ALIGN
#define GEMM_ALIGN true
#endif
#ifndef GEMM_SP2
#define GEMM_SP2 true
#endif
#ifndef WGM_S
#define WGM_S 8
#endif
#ifndef REV_D
#define REV_D 0
#endif
#ifndef WGM_GU
#define WGM_GU 8
#endif
#ifndef WGM_WIN
#define WGM_WIN 8
#endif
#ifndef WGM_D
#define WGM_D 4
#endif
#ifndef FCH
#define FCH 1
#endif
constexpr int MC = M / FCH;
enum { P_N1 = 0, P_F1 = 1, P_N2 = P_F1 + FCH + 1, P_WIN, P_UQ, P_ATT, P_OAB, P_WOUT, P_N3, P_F2, PH_PER_LAYER = P_F2 + FCH + 1 };
constexpr int N_PHASES = 2 + DEPTH * PH_PER_LAYER;

__global__ void __launch_bounds__(NWAVES * 64, 2) mega_fwd(Args args) {
    extern __shared__ __attribute__((aligned(16))) unsigned char lds_raw[];
    LAS unsigned char* lds = (LAS unsigned char*)lds_raw;
    const int tid = threadIdx.x; const int wave_s = __builtin_amdgcn_readfirstlane(tid >> 6);
    const int G = gridDim.x, bx = blockIdx.x, vcu = (G % 8 == 0) ? (bx % 8) * (G / 8) + bx / 8 : bx;
    P p;
    p.x = (const float*)args.in[0]; p.c = (const float*)args.in[1]; p.pos = (const int*)args.in[2]; p.norm_g = (const float*)args.in[3]; p.w_ada = (const float*)args.in[4]; p.b_ada = (const float*)args.in[5];
    p.w_gu1 = (const float*)args.in[6]; p.w_d1 = (const float*)args.in[7]; p.w_gu2 = (const float*)args.in[8]; p.w_d2 = (const float*)args.in[9]; p.w_in = (const float*)args.in[10]; p.b_gate = (const float*)args.in[11];
    p.sink = (const float*)args.in[12]; p.g_cq = (const float*)args.in[13]; p.g_ckv = (const float*)args.in[14]; p.w_uq = (const float*)args.in[15]; p.w_ukv = (const float*)args.in[16];
    p.w_oa = (const float*)args.in[17]; p.w_ob = (const float*)args.in[18]; p.w_out = (const float*)args.in[19]; p.g_final = (const float*)args.in[20];
    p.out = args.out; p.ws = args.ws;
    unsigned char* ws = args.ws;
    for (int u = tid; u < (LDS_BYTES - LDSCTL_OFF) / 4; u += NWAVES * 64) ((LAS unsigned*)(lds + LDSCTL_OFF))[u] = 0u;
    __syncthreads();
    const int lo = args.ph_lo, hi = args.ph_hi;
    XcdBarrier bar; bar.bar = (unsigned*)(ws + WS_CTL) + CW_BAR; bar.x = 0; bar.st = nullptr;
    if (hi - lo > 1) bar = xcd_barrier_post((unsigned*)(ws + WS_CTL) + CW_BAR, (volatile LAS unsigned*)(lds + LDSCTL_OFF) + 8);
#define IN(k) (lo <= (k) && (k) < hi)
#define STAMP(id) do { } while (0)
#define SEAM(k) do { if (IN(k) && IN((k) + 1)) xcd_barrier(bar); STAMP((k) + 1); } while (0)

#define WSL() ({ unsigned long long w_ = (unsigned long long)ws; asm volatile("" : "+s"(w_)); (unsigned char*)(GAS unsigned char*)w_; })
#define mod   ((float*)(WSL() + WS_MOD))
#define cosA  ((const float*)(WSL() + WS_COSA))
#define sinA  ((const float*)(WSL() + WS_SINA))
#define cosR  ((const float*)(WSL() + WS_COSR))
#define sinR  ((const float*)(WSL() + WS_SINR))
#define H     ((bf16*)p.out)
#define X16   ((_Float16*)(WSL() + WS_X16))
#define big   (WSL() + WS_BIG)
#define ACT   ((bf16*)(big + B_ACT))
#define QA    ((bf16*)(big + B_QA))
#define KA    ((bf16*)(big + B_KA))
#define VA    ((bf16*)(big + B_VA))
#define CQN   ((bf16*)(big + B_CQN))
#define CKVN  ((bf16*)(big + B_CKVN))
#define KR    ((bf16*)(big + B_KR))
#define GATES ((unsigned char*)(big + B_GATES))
#define QBN   ((bf16*)(big + B_QA) + 1024)
#define QBR   ((bf16*)(big + B_QBR))
#define KVB   ((bf16*)(big + B_KVB))
#define MIX   H
#define DELTA ((bf16*)(big + B_DELTA))
#define SSQ   ((float*)(WSL() + WS_SS) + (size_t)(2 * l) * M)
#define SSKV  ((float*)(WSL() + WS_SS) + (size_t)(2 * l + 1) * M)

    STAMP(0);
    if (EN_PRO && IN(0)) { prologue(p, lds, vcu, G, false, wave_s); VM_WAIT(); __syncthreads();
#if REP_PRO
        prologue(p, lds, vcu, G, true, wave_s); VM_WAIT(); __syncthreads();
#endif
    }
    SEAM(0);

#pragma unroll 1
    for (int l = 0; l < DEPTH; ++l) {
        const int pb = 1 + l * PH_PER_LAYER;
#define wl ((const bf16*)(WSL() + WS_W) + (size_t)l * LW_ELEMS)
#define ml (mod + (size_t)l * 8 * NMOD)
        const float* ng = p.norm_g + (size_t)l * 3 * D;
        if (IN(pb + P_N1)) { if (l == 0) thin_phase<false, false>(p.x, X16, DELTA, ml, 0.f, ng, ml + 0 * D, ml + 1 * D, H, vcu, G, wave_s);
                             else thin_phase<true, false, true, true>(X16, X16, DELTA, mod + 8 * D, 0.5f, ng, ml + 0 * D, ml + 1 * D, H, vcu, G, wave_s); }
        SEAM(pb + P_N1);
#pragma unroll 1
        for (int s_ = 0; s_ <= FCH; ++s_) {
            if (IN(pb + P_F1 + s_)) {
                if (s_ > 0) { const int c_ = s_ - 1; pg8::Gemm g{ACT + (size_t)c_ * MC * FF, wl + LW_D1, MC, D, FF}; pg8::StaticOrder S; S.init(MC, D, G, bx, WGM_D); S.rev = REV_D;
                    pg8::EpiPlainBf16 E{DELTA + (size_t)c_ * MC * D, D};
                    pg8::gemm_phase<pg8::EpiPlainBf16, pg8::StaticOrder, GEMM_ALIGN, GEMM_SP2>(lds, g, S, E, wave_s); }
                if (s_ < FCH) { const int c_ = s_; pg8::Gemm g{H + (size_t)c_ * MC * D, wl + LW_GU1, MC, 2 * FF, D}; pg8::StaticOrder S; S.init(MC, 2 * FF, G, bx, WGM_GU); pg8::EpiSwiglu E{ACT + (size_t)c_ * MC * FF, FF};
                    pg8::gemm_phase<pg8::EpiSwiglu, pg8::StaticOrder, GEMM_ALIGN, GEMM_SP2>(lds, g, S, E, wave_s); }
#if REP_GU
                if (s_ < FCH && l == 0) for (int rep = 0; rep < REP_GU; ++rep) { pg8::Gemm g{H, wl + LW_GU1, MC, 2 * FF, D}; pg8::StaticOrder S; S.init(MC, 2 * FF, G, bx, WGM_GU);
#if GU_NULL
                    pg8::EpiNull E{}; pg8::gemm_phase<pg8::EpiNull, pg8::StaticOrder, GEMM_ALIGN, GEMM_SP2>(lds, g, S, E, wave_s);
#else
                    pg8::EpiSwiglu E{ACT, FF}; pg8::gemm_phase<pg8::EpiSwiglu, pg8::StaticOrder, GEMM_ALIGN, GEMM_SP2>(lds, g, S, E, wave_s);
#endif
                }
#endif
            }
            SEAM(pb + P_F1 + s_);
        }
        if (IN(pb + P_N2)) { if (l == 0) thin_phase<true, false, false, true>(p.x, X16, DELTA, ml + 2 * D, 0.5f, ng + D, ml + 3 * D, ml + 4 * D, H, vcu, G, wave_s);
                             else thin_phase<true, false, true, true>(X16, X16, DELTA, ml + 2 * D, 0.5f, ng + D, ml + 3 * D, ml + 4 * D, H, vcu, G, wave_s); }
        SEAM(pb + P_N2);
        if (IN(pb + P_WIN)) { pg8::Gemm g{H, wl + LW_IN, M, WIN_N, D}; pg8::StaticOrder S; S.init(M, WIN_N, G, bx, WGM_WIN);
            pg8::EpiWin E{QA, KA, VA, KR, GATES, CQN, CKVN, SSQ, SSKV, p.g_cq + l * 512, p.g_ckv + l * 512, cosA, sinA, cosR, sinR, p.b_gate + (size_t)l * 2 * D};
            pg8::gemm_phase<pg8::EpiWin, pg8::StaticOrder, ALIGN_WIN, GEMM_SP2>(lds, g, S, E, wave_s); }
#if REP_WIN
        if (IN(pb + P_WIN) && l == 0) for (int rep = 0; rep < REP_WIN; ++rep) { pg8::Gemm g{H, wl + LW_IN, M, WIN_N, D}; pg8::StaticOrder S; S.init(M, WIN_N, G, bx, WGM_WIN);
            pg8::EpiNull E{}; pg8::gemm_phase<pg8::EpiNull, pg8::StaticOrder, GEMM_ALIGN, GEMM_SP2>(lds, g, S, E, wave_s); }
#endif
        SEAM(pb + P_WIN);
        if (IN(pb + P_UQ)) for (int rep = 0; rep < 1 + REP_UQ * (l == 0); ++rep) {
            { pg8::Gemm g{CQN, wl + LW_UQ, M, 1536, 512}; pg8::StaticOrder S; S.init(M, 1536, G, bx); pg8::EpiUq E{QBN, QBR, cosR, sinR, SSQ};
              pg8::gemm_phase<pg8::EpiUq, pg8::StaticOrder, GEMM_ALIGN, GEMM_SP2>(lds, g, S, E, wave_s); }
            { pg8::Gemm g{CKVN, wl + LW_UKV, M, 2048, 512}; pg8::StaticOrder S; S.init(M, 2048, G, bx, WGM_S); pg8::EpiScaledBf16 E{KVB, 2048, SSKV};
              pg8::gemm_phase<pg8::EpiScaledBf16, pg8::StaticOrder, GEMM_ALIGN, GEMM_SP2>(lds, g, S, E, wave_s); }
        }
        SEAM(pb + P_UQ);
        if (IN(pb + P_ATT)) {
            for (int rep = 0; rep < 1 + REP_MLA * (l == 0); ++rep)
            for (int u = vcu; u < NB * 8 * 16; u += G) { const int bh = u >> 4, qb = u & 15, b = bh >> 3, h = bh & 7; const size_t r0 = (size_t)b * SEQ + qb * 256, k0 = (size_t)b * SEQ;
                ATT_MLA_BODY(QBN + r0 * 2048 + h * 128, QBR + r0 * 512 + h * 64, KVB + k0 * 2048 + h * 256, KVB + k0 * 2048 + h * 256 + 128, KR + k0 * 64,
                                                      QBN + r0 * 2048 + h * 128, SEQ / 64, 0.07216878364870322f * 1.4426950408889634f, 8.0f / 0.07216878364870322f, -1e30f, 0.f, 0, 0, (char*)lds_raw, wave_s); }
            for (int rep = 0; rep < 1 + REP_SWA * (l == 0); ++rep)
            for (int u = vcu; u < NB * 8 * 16; u += G) { const int bh = u >> 4, qb = u & 15, b = bh >> 3, h = bh & 7, i0 = qb * 256; const size_t r0 = (size_t)b * SEQ + i0;
                const int klo = i0 >= 128 ? i0 - 128 : 0, khi = i0 + 384 <= SEQ ? i0 + 384 : SEQ; const size_t k0 = (size_t)b * SEQ + klo;
                const float sk = p.sink[l * 8 + h];
                ATT_SWA_BODY(QA + r0 * 2048 + h * 128, nullptr, KA + k0 * 256 + (h >> 2) * 128, VA + k0 * 256 + (h >> 2) * 128, nullptr,
                                                      QA + r0 * 2048 + h * 128, (khi - klo) / 64, 0.08838834764831845f * 1.4426950408889634f, 8.0f / 0.08838834764831845f, sk / 0.08838834764831845f, 1.f, i0, klo, (char*)lds_raw, wave_s); }
        }
        SEAM(pb + P_ATT);
        if (IN(pb + P_OAB)) { pg8::Gemm g{QA, wl + LW_OA, M, D, 2048}; pg8::StaticOrder S; S.init(M, D, G, bx, WGM_S); pg8::EpiGateMerge E{GATES, MIX};
            pg8::gemm_phase<pg8::EpiGateMerge, pg8::StaticOrder, GEMM_ALIGN, GEMM_SP2>(lds, g, S, E, wave_s); }
        SEAM(pb + P_OAB);
        if (IN(pb + P_WOUT)) { pg8::Gemm g{MIX, wl + LW_OUT, M, D, D}; pg8::StaticOrder S; S.init(M, D, G, bx, WGM_S); pg8::EpiPlainBf16 E{DELTA, D};
            pg8::gemm_phase<pg8::EpiPlainBf16, pg8::StaticOrder, GEMM_ALIGN, GEMM_SP2>(lds, g, S, E, wave_s); }
        SEAM(pb + P_WOUT);
        if (IN(pb + P_N3)) thin_phase<true, false, true, true>(X16, X16, DELTA, ml + 5 * D, 1.0f, ng + 2 * D, ml + 6 * D, ml + 7 * D, H, vcu, G, wave_s);
        SEAM(pb + P_N3);
#pragma unroll 1
        for (int s_ = 0; s_ <= FCH; ++s_) {
            if (IN(pb + P_F2 + s_)) {
                if (s_ > 0) { const int c_ = s_ - 1; pg8::Gemm g{ACT + (size_t)c_ * MC * FF, wl + LW_D2, MC, D, FF}; pg8::StaticOrder S; S.init(MC, D, G, bx, WGM_D); S.rev = REV_D;
                    pg8::EpiPlainBf16 E{DELTA + (size_t)c_ * MC * D, D};
                    pg8::gemm_phase<pg8::EpiPlainBf16, pg8::StaticOrder, GEMM_ALIGN, GEMM_SP2>(lds, g, S, E, wave_s); }
                if (s_ < FCH) { const int c_ = s_; pg8::Gemm g{H + (size_t)c_ * MC * D, wl + LW_GU2, MC, 2 * FF, D}; pg8::StaticOrder S; S.init(MC, 2 * FF, G, bx, WGM_GU); pg8::EpiSwiglu E{ACT + (size_t)c_ * MC * FF, FF};
                    pg8::gemm_phase<pg8::EpiSwiglu, pg8::StaticOrder, GEMM_ALIGN, GEMM_SP2>(lds, g, S, E, wave_s); }
            }
            SEAM(pb + P_F2 + s_);
        }
    }
    if (IN(N_PHASES - 1)) thin_phase<true, true, true, false>(X16, p.out, DELTA, mod + (size_t)8 * NMOD + 8 * D, 0.5f, p.g_final, p.g_final, p.g_final, H, vcu, G, wave_s);
#undef IN
#undef SEAM
}

extern "C" void kernel_launch(void* const* d_in, const int* in_sizes, int n_in, void* d_out, int out_size, void* d_ws, size_t ws_size, hipStream_t stream) {
    static int grid = 0;
    if (grid == 0) {
        if (n_in != 21 || in_sizes[0] != M * D || out_size != M * D || ws_size < WS_END) {
            fprintf(stderr, "kernel_launch: built for 21 inputs, x/out of %d floats, >= %zu bytes of workspace; got n_in %d, in0 %d, out %d, ws %zu; nothing launched\n", M * D, (size_t)WS_END, n_in, n_in > 0 ? in_sizes[0] : -1, out_size, ws_size);
            grid = -1; return; }
        int dev = 0, cus = 0, per_cu = 0;
        if (hipGetDevice(&dev) != hipSuccess || hipDeviceGetAttribute(&cus, hipDeviceAttributeMultiprocessorCount, dev) != hipSuccess) { fprintf(stderr, "kernel_launch: device query failed\n"); grid = -1; return; }
        if (hipFuncSetAttribute((const void*)mega_fwd, hipFuncAttributeMaxDynamicSharedMemorySize, LDS_BYTES) != hipSuccess) { fprintf(stderr, "kernel_launch: hipFuncSetAttribute failed\n"); grid = -1; return; }
        if (hipOccupancyMaxActiveBlocksPerMultiprocessor(&per_cu, (const void*)mega_fwd, NWAVES * 64, LDS_BYTES) != hipSuccess || per_cu < 1)
            fprintf(stderr, "kernel_launch: note: occupancy query reports %d workgroups per CU\n", per_cu);
        (void)hipGetLastError();
        grid = cus;
    }
    if (grid < 0) return;
    if (hipMemsetAsync((char*)d_ws + WS_CTL, 0, WS_ZERO_BYTES, stream) != hipSuccess) { fprintf(stderr, "kernel_launch: memset failed\n"); return; }
    Args a{};
    for (int i = 0; i < 21; ++i) a.in[i] = d_in[i];
    a.out = (float*)d_out; a.ws = (unsigned char*)d_ws;
#if MK_ONE_LAUNCH
    a.ph_lo = 0; a.ph_hi = N_PHASES;
    hipLaunchKernelGGL(mega_fwd, dim3(grid), dim3(NWAVES * 64), LDS_BYTES, stream, a);
#else
    for (int ph = 0; ph < N_PHASES; ++ph) { a.ph_lo = ph; a.ph_hi = ph + 1;
        hipLaunchKernelGGL(mega_fwd, dim3(grid), dim3(NWAVES * 64), LDS_BYTES, stream, a);
    }
#endif
    const hipError_t le = hipPeekAtLastError();
    if (le != hipSuccess) fprintf(stderr, "kernel_launch: launch failed: %s\n", hipGetErrorName(le));
}
```

```cpp
#include <hip/hip_runtime.h>
#include <cstdio>
#include <cstdint>
#include <cmath>

#ifndef MERGE_MID
#define MERGE_MID true
#endif
#ifndef MK_ONE_LAUNCH
#define MK_ONE_LAUNCH 1
#endif

__device__ __forceinline__ int lane_id_fresh() { int l; asm volatile("v_mbcnt_lo_u32_b32 %0, -1, 0\n\tv_mbcnt_hi_u32_b32 %0, -1, %0" : "=v"(l)); return l; }

namespace pg8 {
#define PG8_LAS __attribute__((address_space(3)))
typedef unsigned short bf16_t;
typedef short bf16x8 __attribute__((ext_vector_type(8)));
typedef float f32x4 __attribute__((ext_vector_type(4)));
typedef unsigned u32x4 __attribute__((ext_vector_type(4)));
constexpr int BM = 256, BK = 64, HALF = 128, HTB = HALF * BK * 2  , STAGE_BYTES = 8 * HTB, NXCD = 8, WGM = 8;

__host__ __device__ __forceinline__ int lds_byte(int r, int c) { const int st = (r >> 4) * 2 + (c >> 5), rr = r & 15, cc = c & 31, ob = rr * 64 + cc * 2; return st * 1024 + (ob ^ (((ob >> 9) & 1) << 5)); }
__host__ __device__ __forceinline__ void stage_rc(int b, int& R, int& C) { const int st = b / 1024, sb = b % 1024, swz = sb ^ (((sb >> 9) & 1) << 5); R = (st >> 1) * 16 + swz / 64; C = (st & 1) * 32 + (swz % 64) / 2; }
__host__ __device__ __forceinline__ int perm32(int rho) { const int n = rho >> 4, i = rho & 15; return 8 * (i >> 2) + 4 * n + (i & 3); }

struct Unit { int pm, pn; };
struct Gemm { const bf16_t* A; const bf16_t* Bt; int M, N, K; };

struct StaticOrder {
    int nM, nN, nwg, G, c, wgm, rev;
    int pad_;
    __host__ __device__ void init(int M, int N, int G_, int c_, int wgm_ = WGM) { nM = M / BM; nN = N / BM; nwg = nM * nN; G = G_; c = c_; wgm = wgm_; rev = 0; pad_ = 0; }
    __host__ __device__ bool next(int i, Unit& u) const {
        const long L = (long)i * G + c; if (L >= nwg) return false;
        int wgid = (int)L; { const int q = nwg / NXCD, r = nwg % NXCD, xcd = wgid % NXCD, off = wgid / NXCD; wgid = (xcd < r ? xcd * (q + 1) : r * (q + 1) + (xcd - r) * q) + off; }
        const int nig = wgm * nN, gid = wgid / nig, fm = gid * wgm, gsz = (nM - fm) < wgm ? (nM - fm) : wgm;
        u.pm = fm + ((wgid % nig) % gsz); u.pn = (wgid % nig) / gsz; if (rev) u.pm = nM - 1 - u.pm; return true;
    }
    __device__ __forceinline__ void a_ready(const Unit&) const {}
    __device__ __forceinline__ void done(const Unit&) const {}
};
typedef __bf16 bf16x2_t __attribute__((ext_vector_type(2)));
__device__ __forceinline__ unsigned cvt_pk_bf16(float lo, float hi) { const float __attribute__((ext_vector_type(2))) v = {lo, hi}; return __builtin_bit_cast(unsigned, __builtin_convertvector(v, bf16x2_t)); }
typedef float f32x2 __attribute__((ext_vector_type(2)));
typedef unsigned u32x2 __attribute__((ext_vector_type(2)));
__device__ __forceinline__ float bf_lo(unsigned w) { return __uint_as_float(w << 16); }
__device__ __forceinline__ float bf_hi(unsigned w) { return __uint_as_float(w & 0xffff0000u); }
__device__ __forceinline__ float fast_sigmoid(float x) { return __builtin_amdgcn_rcpf(1.0f + __builtin_amdgcn_exp2f(-1.4426950408889634f * x)); }
__device__ __forceinline__ f32x2 fast_sigmoid2(f32x2 x) {
    const f32x2 t = x * (f32x2){-1.4426950408889634f, -1.4426950408889634f}; f32x2 e = {__builtin_amdgcn_exp2f(t.x), __builtin_amdgcn_exp2f(t.y)};
    e += (f32x2){1.0f, 1.0f}; return (f32x2){__builtin_amdgcn_rcpf(e.x), __builtin_amdgcn_rcpf(e.y)}; }
__device__ __forceinline__ u32x4 pack8(const f32x4 a, const f32x4 b) { u32x4 w; w.x = cvt_pk_bf16(a[0], a[1]); w.y = cvt_pk_bf16(a[2], a[3]); w.z = cvt_pk_bf16(b[0], b[1]); w.w = cvt_pk_bf16(b[2], b[3]); return w; }

struct EpiSwiglu {
    static constexpr bool PERM = true, AFTER_DRAIN = false, MID = false;
    bf16_t* O; int ldc;
    __device__ __forceinline__ void operator()(const f32x4 (&acc)[2][2][4][2], const Unit& u, int wr, int wc, int fr, int fq) const {
        const int row0 = u.pm * BM + wr * 64 + fr, col0 = u.pn * HALF + wc * 32 + 8 * fq;
#pragma unroll
        for (int ai = 0; ai < 2; ++ai)
#pragma unroll
            for (int m = 0; m < 4; ++m) { bf16_t* rowp = O + (size_t)(row0 + ai * HALF + m * 16) * ldc + col0;
                f32x4 v[2];
#pragma unroll
                for (int n = 0; n < 2; ++n) { const f32x4 g = acc[ai][0][m][n], up = acc[ai][1][m][n];
#pragma unroll
                    for (int i = 0; i < 4; i += 2) { const f32x2 g2 = {g[i], g[i + 1]}, o2 = g2 * fast_sigmoid2(g2) * (f32x2){up[i], up[i + 1]}; v[n][i] = o2.x; v[n][i + 1] = o2.y; } }
                *(u32x4*)rowp = pack8(v[0], v[1]); }
    }
};

struct EpiPlainBf16 {
    static constexpr bool PERM = true, AFTER_DRAIN = false, MID = false;
    bf16_t* O; int ldc;
    __device__ __forceinline__ void operator()(const f32x4 (&acc)[2][2][4][2], const Unit& u, int wr, int wc, int fr, int fq) const {
        const int row0 = u.pm * BM + wr * 64 + fr, col0 = u.pn * BM + wc * 32 + 8 * fq;
#pragma unroll
        for (int ai = 0; ai < 2; ++ai)
#pragma unroll
            for (int m = 0; m < 4; ++m) { bf16_t* rowp = O + (size_t)(row0 + ai * HALF + m * 16) * ldc + col0;
#pragma unroll
                for (int bj = 0; bj < 2; ++bj) *(u32x4*)(rowp + bj * HALF) = pack8(acc[ai][bj][m][0], acc[ai][bj][m][1]); }
    }
};

template <int NF> __device__ __forceinline__ void rope_store(const f32x4 (&acc)[2][2][4][2], int ai, int m, const float* cosT, const float* sinT, size_t row, int d0, bf16_t* o1p, bf16_t* o2p) {
    const f32x4 c0 = *(const f32x4*)(cosT + row * NF + d0), c1 = *(const f32x4*)(cosT + row * NF + d0 + 4);
    const f32x4 s0 = *(const f32x4*)(sinT + row * NF + d0), s1 = *(const f32x4*)(sinT + row * NF + d0 + 4);
    const f32x4 a0 = acc[ai][0][m][0], a1 = acc[ai][0][m][1], b0 = acc[ai][1][m][0], b1 = acc[ai][1][m][1];
    const f32x4 r0 = a0 * c0 - b0 * s0, r1 = a1 * c1 - b1 * s1, q0 = b0 * c0 + a0 * s0, q1 = b1 * c1 + a1 * s1;
    *(u32x4*)o1p = pack8(r0, r1); *(u32x4*)o2p = pack8(q0, q1);
}

struct EpiWin {
    static constexpr bool PERM = true, AFTER_DRAIN = false, MID = false;
    bf16_t *QA, *KA, *VA, *KR; unsigned char* GATES; bf16_t *CQN, *CKVN; float *SSQ, *SSKV; const float *gq, *gkv, *cosA, *sinA, *cosR, *sinR, *bgate;
    __device__ __forceinline__ void operator()(const f32x4 (&acc)[2][2][4][2], const Unit& u, int wr, int wc, int fr, int fq) const {
        const int row0 = u.pm * BM + wr * 64 + fr, pn = u.pn;
        if (pn <= 4) {
            const int hsel = wc >> 1, d0 = 32 * (wc & 1) + 8 * fq;
            bf16_t* base; int ld, head;
            if (pn < 4) { base = QA; ld = 2048; head = 2 * pn + hsel; } else { base = KA; ld = 256; head = hsel; }
#pragma unroll
            for (int ai = 0; ai < 2; ++ai)
#pragma unroll
                for (int m = 0; m < 4; ++m) { const size_t row = (size_t)(row0 + ai * HALF + m * 16); bf16_t* o1 = base + row * ld + head * 128 + d0;
                    rope_store<64>(acc, ai, m, cosA, sinA, row, d0, o1, o1 + 64); }
        } else if (pn == 5) {
            const int col0 = wc * 32 + 8 * fq;
#pragma unroll
            for (int ai = 0; ai < 2; ++ai)
#pragma unroll
                for (int m = 0; m < 4; ++m) { bf16_t* rowp = VA + (size_t)(row0 + ai * HALF + m * 16) * 256 + col0;
#pragma unroll
                    for (int bj = 0; bj < 2; ++bj) *(u32x4*)(rowp + bj * HALF) = pack8(acc[ai][bj][m][0], acc[ai][bj][m][1]); }
        } else if (pn <= 9) {
            bf16_t* base = pn <= 7 ? CQN : CKVN; float* ssp = pn <= 7 ? SSQ : SSKV; const float* gp = (pn <= 7 ? gq : gkv); const int col0 = ((pn - 6) & 1) * 256 + wc * 32 + 8 * fq;
            f32x4 gv[2][2];
#pragma unroll
            for (int bj = 0; bj < 2; ++bj)
#pragma unroll
                for (int n = 0; n < 2; ++n) gv[bj][n] = *(const f32x4*)(gp + col0 + bj * HALF + 4 * n);
#pragma unroll
            for (int ai = 0; ai < 2; ++ai)
#pragma unroll
                for (int m = 0; m < 4; ++m) { const size_t row = (size_t)(row0 + ai * HALF + m * 16); bf16_t* rowp = base + row * 512 + col0; float ssq = 0.f;
#pragma unroll
                    for (int bj = 0; bj < 2; ++bj) {
#pragma unroll
                        for (int n = 0; n < 2; ++n) { const f32x4 t = acc[ai][bj][m][n]; ssq += (t[0] * t[0] + t[1] * t[1]) + (t[2] * t[2] + t[3] * t[3]); }
                        *(u32x4*)(rowp + bj * HALF) = pack8(acc[ai][bj][m][0] * gv[bj][0], acc[ai][bj][m][1] * gv[bj][1]); }
                    { auto r = __builtin_amdgcn_permlane16_swap(__float_as_uint(ssq), __float_as_uint(ssq), false, false); ssq = __uint_as_float(r[0]) + __uint_as_float(r[1]); }
                    { auto r = __builtin_amdgcn_permlane32_swap(__float_as_uint(ssq), __float_as_uint(ssq), false, false); ssq = __uint_as_float(r[0]) + __uint_as_float(r[1]); }
                    if (fq == 0) unsafeAtomicAdd(ssp + row, ssq); }
        } else if (pn == 10) {
            if (wc == 0) { const int d0 = 8 * fq;
#pragma unroll
                for (int ai = 0; ai < 2; ++ai)
#pragma unroll
                    for (int m = 0; m < 4; ++m) { const size_t row = (size_t)(row0 + ai * HALF + m * 16); bf16_t* o1 = KR + row * 64 + d0;
                        rope_store<32>(acc, ai, m, cosR, sinR, row, d0, o1, o1 + 32); } }
        } else {
            const int col0 = (pn - 11) * 256 + wc * 32 + 8 * fq;
            f32x4 bv[2][2];
#pragma unroll
            for (int bj = 0; bj < 2; ++bj)
#pragma unroll
                for (int n = 0; n < 2; ++n) bv[bj][n] = *(const f32x4*)(bgate + col0 + bj * HALF + 4 * n);
#pragma unroll
            for (int ai = 0; ai < 2; ++ai)
#pragma unroll
                for (int m = 0; m < 4; ++m) { unsigned char* rowp = GATES + (size_t)(row0 + ai * HALF + m * 16) * 4096 + col0;
#pragma unroll
                    for (int bj = 0; bj < 2; ++bj) { u32x2 w;
#pragma unroll
                        for (int n = 0; n < 2; ++n) { const f32x4 t = acc[ai][bj][m][n] + bv[bj][n]; unsigned q[4];
#pragma unroll
                            for (int i = 0; i < 4; i += 2) { const f32x2 s2 = __builtin_elementwise_fma(fast_sigmoid2((f32x2){t[i], t[i + 1]}), (f32x2){255.0f, 255.0f}, (f32x2){8388608.0f, 8388608.0f});
                                q[i] = __float_as_uint(s2.x); q[i + 1] = __float_as_uint(s2.y); }
                            w[n] = __builtin_amdgcn_perm(q[1], q[0], 0x0c0c0400u) | __builtin_amdgcn_perm(q[3], q[2], 0x04000c0cu); }
                        *(u32x2*)(rowp + bj * HALF) = w; } }
        }
    }
};

__device__ __forceinline__ void row_rstd512(const float* ss, int row0, float (&rs)[2][4]) {
#pragma unroll
    for (int ai = 0; ai < 2; ++ai)
#pragma unroll
        for (int m = 0; m < 4; ++m) rs[ai][m] = 1.0f / sqrtf(ss[row0 + ai * HALF + m * 16] * (1.0f / 512.0f) + 1e-6f);
}
struct EpiUq {
    static constexpr bool PERM = true, AFTER_DRAIN = false, MID = false;
    bf16_t *QBN, *QBR; const float *cosR, *sinR, *ss;
    __device__ __forceinline__ void operator()(f32x4 (&acc)[2][2][4][2], const Unit& u, int wr, int wc, int fr, int fq) const {
        const int row0 = u.pm * BM + wr * 64 + fr, pn = u.pn;
        float rs[2][4]; row_rstd512(ss, row0, rs);
#pragma unroll
        for (int ai = 0; ai < 2; ++ai)
#pragma unroll
            for (int m = 0; m < 4; ++m)
#pragma unroll
                for (int bj = 0; bj < 2; ++bj)
#pragma unroll
                    for (int n = 0; n < 2; ++n) acc[ai][bj][m][n] = acc[ai][bj][m][n] * rs[ai][m];
        if (pn < 4) {
            const int col0 = pn * BM + wc * 32 + 8 * fq;
#pragma unroll
            for (int ai = 0; ai < 2; ++ai)
#pragma unroll
                for (int m = 0; m < 4; ++m) { bf16_t* rowp = QBN + (size_t)(row0 + ai * HALF + m * 16) * 2048 + col0;
#pragma unroll
                    for (int bj = 0; bj < 2; ++bj) *(u32x4*)(rowp + bj * HALF) = pack8(acc[ai][bj][m][0], acc[ai][bj][m][1]); }
        } else {
            const int head = 4 * (pn - 4) + wc, d0 = 8 * fq;
#pragma unroll
            for (int ai = 0; ai < 2; ++ai)
#pragma unroll
                for (int m = 0; m < 4; ++m) { const size_t row = (size_t)(row0 + ai * HALF + m * 16); bf16_t* o1 = QBR + row * 512 + head * 64 + d0;
                    rope_store<32>(acc, ai, m, cosR, sinR, row, d0, o1, o1 + 32); }
        }
    }
};
struct EpiScaledBf16 {
    static constexpr bool PERM = true, AFTER_DRAIN = false, MID = false;
    bf16_t* O; int ldc; const float* ss;
    __device__ __forceinline__ void operator()(const f32x4 (&acc)[2][2][4][2], const Unit& u, int wr, int wc, int fr, int fq) const {
        const int row0 = u.pm * BM + wr * 64 + fr, col0 = u.pn * BM + wc * 32 + 8 * fq;
        float rs[2][4]; row_rstd512(ss, row0, rs);
#pragma unroll
        for (int ai = 0; ai < 2; ++ai)
#pragma unroll
            for (int m = 0; m < 4; ++m) { bf16_t* rowp = O + (size_t)(row0 + ai * HALF + m * 16) * ldc + col0;
#pragma unroll
                for (int bj = 0; bj < 2; ++bj) *(u32x4*)(rowp + bj * HALF) = pack8(acc[ai][bj][m][0] * rs[ai][m], acc[ai][bj][m][1] * rs[ai][m]); }
    }
};

struct EpiGateMerge {
    static constexpr bool PERM = true, AFTER_DRAIN = false, MID = MERGE_MID;
    const unsigned char* G; bf16_t* O;
    static __device__ __forceinline__ f32x4 ub4(unsigned w) { return (f32x4){(float)(w & 0xffu), (float)((w >> 8) & 0xffu), (float)((w >> 16) & 0xffu), (float)(w >> 24)}; }
    __device__ __forceinline__ void mid(f32x4 (&acc)[2][2][4][2], const Unit& u, int wr, int wc, int fr_, int fq_) const {
        int fr = fr_, fq = fq_; asm volatile("" : "+v"(fr), "+v"(fq));
        const int row0 = u.pm * BM + wr * 64 + fr, col0 = u.pn * BM + wc * 32 + 8 * fq;
#pragma unroll
        for (int ai = 0; ai < 2; ++ai) {
            u32x2 ga[4][2], gb[4][2];
#pragma unroll
            for (int m = 0; m < 4; ++m) { const unsigned char* gp = G + (size_t)(row0 + ai * HALF + m * 16) * 4096 + col0;
#pragma unroll
                for (int bj = 0; bj < 2; ++bj) { ga[m][bj] = *(const u32x2*)(gp + bj * HALF); gb[m][bj] = *(const u32x2*)(gp + 2048 + bj * HALF); } }
#pragma unroll
            for (int m = 0; m < 4; ++m)
#pragma unroll
                for (int bj = 0; bj < 2; ++bj) { const u32x2 A = ga[m][bj], Bv = gb[m][bj];
                    const f32x4 a0 = ub4(A.x), a1 = ub4(A.y);
                    f32x4 b0 = ub4(Bv.x), b1 = ub4(Bv.y);
#pragma unroll
                    for (int i = 0; i < 4; ++i) { b0[i] = fmaxf(b0[i], 1e-30f); b1[i] = fmaxf(b1[i], 1e-30f); }
#pragma unroll
                    for (int i = 0; i < 4; ++i) { acc[ai][bj][m][0][i] *= a0[i] * __builtin_amdgcn_rcpf(b0[i]); acc[ai][bj][m][1][i] *= a1[i] * __builtin_amdgcn_rcpf(b1[i]); } }
            asm volatile("" ::: "memory");
        }
    }
    __device__ __forceinline__ void operator()(const f32x4 (&acc)[2][2][4][2], const Unit& u, int wr, int wc, int fr, int fq) const {
        const int row0 = u.pm * BM + wr * 64 + fr, col0 = u.pn * BM + wc * 32 + 8 * fq;
#pragma unroll
        for (int ai = 0; ai < 2; ++ai)
#pragma unroll
            for (int m = 0; m < 4; ++m) { const size_t row = (size_t)(row0 + ai * HALF + m * 16);
#pragma unroll
                for (int bj = 0; bj < 2; ++bj) { const int col = col0 + bj * HALF; const u32x2 gb = *(const u32x2*)(G + row * 4096 + 2048 + col);
                    f32x4 g0 = ub4(gb.x), g1 = ub4(gb.y);
#pragma unroll
                    for (int i = 0; i < 4; ++i) { g0[i] = fmaxf(g0[i], 1e-30f) * (1.0f / 255.0f); g1[i] = fmaxf(g1[i], 1e-30f) * (1.0f / 255.0f); }
                    const f32x4 v0 = acc[ai][bj][m][0] * g0, v1 = acc[ai][bj][m][1] * g1;
                    *(u32x4*)(O + row * 2048 + col) = pack8(v0, v1); } }
    }
};
template <class Epi, class Sched, bool ALIGN_EPI = false, bool SP2 = false>
__device__ __forceinline__ void gemm_phase(PG8_LAS unsigned char* lds, const Gemm g, const Sched& S, const Epi& E, const int wave_s) {
    int tid_ = wave_s * 64 + lane_id_fresh(); asm volatile("" : "+v"(tid_));
    const int tid = tid_, wid = __builtin_amdgcn_readfirstlane(tid >> 6), lane = tid & 63, wr = wid >> 2, wc = wid & 3, fr = lane & 15, fq = lane >> 4;
    const int K = g.K, nt = K / BK;
    unsigned voffA[2], voffB[2];
#pragma unroll
    for (int i = 0; i < 2; ++i) { int R, C; stage_rc(tid * 16 + i * 8192, R, C); const int Rb = Epi::PERM ? ((R & ~31) + perm32(R & 31)) : R;
        voffA[i] = (unsigned)(R * K + C) * 2u; voffB[i] = (unsigned)(Rb * K + C) * 2u; }
    const size_t kstep = (size_t)(BK * 2);
    const size_t hstep = (size_t)HALF * K * 2;
    const size_t tstep = 2 * hstep;
    const unsigned ldsw = (unsigned)wid * 1024u;
    const int aoff = lds_byte(wr * 64 + fr, fq * 8), boff = lds_byte(wc * 32 + fr, fq * 8);
#define PG8_SA(b, h) (((b) * 2 + (h)) * HTB)
#define PG8_SB(b, h) ((4 + (b) * 2 + (h)) * HTB)
#define PG8_STAGE(bufoff, gbase, voff) do { _Pragma("unroll") for (int _i = 0; _i < 2; ++_i) \
        __builtin_amdgcn_global_load_lds((const unsigned*)((const char*)(gbase) + (voff)[_i]), (PG8_LAS unsigned*)(lds + (bufoff) + ldsw + _i * 8192), 16, 0, 0); } while (0)
#define PG8_LDA(dst, b, h) do { _Pragma("unroll") for (int m = 0; m < 4; ++m) _Pragma("unroll") for (int k = 0; k < 2; ++k) dst[m][k] = *(const PG8_LAS bf16x8*)(lds + PG8_SA(b, h) + aoff + m * 2048 + k * 1024); } while (0)
#define PG8_LDB(dst, b, h) do { _Pragma("unroll") for (int n = 0; n < 2; ++n) _Pragma("unroll") for (int k = 0; k < 2; ++k) dst[n][k] = *(const PG8_LAS bf16x8*)(lds + PG8_SB(b, h) + boff + n * 2048 + k * 1024); } while (0)
#define PG8_MMA(ai, bj, At, Bt) do { __builtin_amdgcn_s_setprio(1); _Pragma("unroll") for (int m = 0; m < 4; ++m) _Pragma("unroll") for (int n = 0; n < 2; ++n) _Pragma("unroll") for (int k = 0; k < 2; ++k) \
        acc[ai][bj][m][n] = __builtin_amdgcn_mfma_f32_16x16x32_bf16(Bt[n][k], At[m][k], acc[ai][bj][m][n], 0, 0, 0); __builtin_amdgcn_s_setprio(0); } while (0)
#define PG8_WAIT_V(n) asm volatile("s_waitcnt vmcnt(" #n ")" ::: "memory")
#define PG8_WAIT_L(n) asm volatile("s_waitcnt lgkmcnt(" #n ")" ::: "memory")
#define PG8_BAR __builtin_amdgcn_s_barrier()
#define PG8_SCHED __builtin_amdgcn_sched_barrier(0)
    Unit cur, nxt; int ui = 0;
    if (!S.next(0, cur)) return;
    f32x4 acc[2][2][4][2];
#pragma unroll
    for (int a = 0; a < 2; ++a)
#pragma unroll
        for (int b = 0; b < 2; ++b)
#pragma unroll
            for (int m = 0; m < 4; ++m)
#pragma unroll
                for (int n = 0; n < 2; ++n) acc[a][b][m][n] = (f32x4){0.f, 0.f, 0.f, 0.f};
    bf16x8 At[4][2], B0[2][2], B1[2][2];
    const char* cA = (const char*)g.A + (size_t)cur.pm * tstep; const char* cB = (const char*)g.Bt + (size_t)cur.pn * tstep;
    S.a_ready(cur);
    if constexpr (SP2) {
        PG8_STAGE(PG8_SB(0, 0), cB, voffB); PG8_STAGE(PG8_SB(0, 1), cB + hstep, voffB); PG8_STAGE(PG8_SA(0, 0), cA, voffA); PG8_STAGE(PG8_SA(0, 1), cA + hstep, voffA);
        if (wr == 1) PG8_BAR;
        PG8_WAIT_V(2); PG8_BAR;
        PG8_STAGE(PG8_SB(1, 0), cB + kstep, voffB); PG8_STAGE(PG8_SA(1, 0), cA + kstep, voffA); PG8_STAGE(PG8_SB(1, 1), cB + hstep + kstep, voffB);
        PG8_WAIT_V(6); PG8_BAR;
    } else {
        PG8_STAGE(PG8_SB(0, 0), cB, voffB); PG8_STAGE(PG8_SA(0, 0), cA, voffA); PG8_STAGE(PG8_SB(0, 1), cB + hstep, voffB); PG8_STAGE(PG8_SA(0, 1), cA + hstep, voffA);
        if (wr == 1) PG8_BAR;
        PG8_WAIT_V(4); PG8_BAR;
        PG8_STAGE(PG8_SB(1, 0), cB + kstep, voffB); PG8_STAGE(PG8_SA(1, 0), cA + kstep, voffA); PG8_STAGE(PG8_SB(1, 1), cB + hstep + kstep, voffB);
        PG8_WAIT_V(6); PG8_BAR;
    }
    for (;;) {
        const bool has_next = S.next(ui + 1, nxt);
        const char* nA = has_next ? (const char*)g.A + (size_t)nxt.pm * tstep : cA; const char* nB = has_next ? (const char*)g.Bt + (size_t)nxt.pn * tstep : cB;
        for (int t = 0; t < nt; t += 2) {
            const bool last = (t == nt - 2);
            const char* a1 = cA + (size_t)(t + 1) * kstep;
            const char* a2 = last ? nA : cA + (size_t)(t + 2) * kstep; const char* b2 = last ? nB : cB + (size_t)(t + 2) * kstep;
            const char* a3 = a2 + kstep; const char* b3 = b2 + kstep;
            if (last && has_next) S.a_ready(nxt);
            if constexpr (SP2) {
            PG8_LDB(B0, 0, 0); PG8_LDB(B1, 0, 1); PG8_SCHED; PG8_LDA(At, 0, 0); PG8_STAGE(PG8_SA(1, 1), a1 + hstep, voffA);
            PG8_WAIT_V(8); PG8_WAIT_L(0); PG8_BAR; PG8_MMA(0, 0, At, B0); PG8_MMA(0, 1, At, B1); PG8_BAR; PG8_SCHED;
            PG8_LDA(At, 0, 1); PG8_STAGE(PG8_SB(0, 0), b2, voffB); PG8_STAGE(PG8_SB(0, 1), b2 + hstep, voffB); PG8_STAGE(PG8_SA(0, 0), a2, voffA);
            PG8_WAIT_V(8); PG8_WAIT_L(0); PG8_BAR; PG8_MMA(1, 0, At, B0); PG8_MMA(1, 1, At, B1); PG8_BAR; PG8_SCHED;
            PG8_LDB(B0, 1, 0); PG8_LDB(B1, 1, 1); PG8_SCHED; PG8_LDA(At, 1, 0); PG8_STAGE(PG8_SA(0, 1), a2 + hstep, voffA);
            PG8_WAIT_V(8); PG8_WAIT_L(0); PG8_BAR; PG8_MMA(0, 0, At, B0); PG8_MMA(0, 1, At, B1); PG8_BAR; PG8_SCHED;
            PG8_LDA(At, 1, 1); PG8_STAGE(PG8_SB(1, 0), b3, voffB); PG8_STAGE(PG8_SB(1, 1), b3 + hstep, voffB); PG8_STAGE(PG8_SA(1, 0), a3, voffA);
            PG8_WAIT_V(8); PG8_WAIT_L(0); PG8_BAR; PG8_MMA(1, 0, At, B0); PG8_MMA(1, 1, At, B1); PG8_BAR; PG8_SCHED;
            } else {
            PG8_LDB(B0, 0, 0); PG8_SCHED; PG8_LDA(At, 0, 0); PG8_STAGE(PG8_SA(1, 1), a1 + hstep, voffA);
            PG8_WAIT_L(8); PG8_BAR; PG8_WAIT_L(0); PG8_MMA(0, 0, At, B0); PG8_BAR; PG8_SCHED;
            PG8_LDB(B1, 0, 1); PG8_STAGE(PG8_SB(0, 0), b2, voffB);
            PG8_BAR; PG8_WAIT_L(0); PG8_MMA(0, 1, At, B1); PG8_BAR;
            PG8_LDA(At, 0, 1); PG8_STAGE(PG8_SA(0, 0), a2, voffA);
            PG8_BAR; PG8_WAIT_L(0); PG8_MMA(1, 0, At, B0); PG8_BAR; PG8_SCHED;
            PG8_STAGE(PG8_SB(0, 1), b2 + hstep, voffB);
            PG8_WAIT_V(6); PG8_BAR; PG8_MMA(1, 1, At, B1); PG8_BAR;
            PG8_LDB(B0, 1, 0); PG8_SCHED; PG8_LDA(At, 1, 0); PG8_STAGE(PG8_SA(0, 1), a2 + hstep, voffA);
            PG8_WAIT_L(8); PG8_BAR; PG8_WAIT_L(0); PG8_MMA(0, 0, At, B0); PG8_BAR; PG8_SCHED;
            PG8_LDB(B1, 1, 1); PG8_STAGE(PG8_SB(1, 0), b3, voffB);
            PG8_BAR; PG8_WAIT_L(0); PG8_MMA(0, 1, At, B1); PG8_BAR;
            PG8_LDA(At, 1, 1); PG8_STAGE(PG8_SA(1, 0), a3, voffA);
            PG8_BAR; PG8_WAIT_L(0); PG8_MMA(1, 0, At, B0); PG8_BAR; PG8_SCHED;
            PG8_STAGE(PG8_SB(1, 1), b3 + hstep, voffB);
            PG8_WAIT_V(6); PG8_BAR; PG8_MMA(1, 1, At, B1); PG8_BAR;
            }
            if constexpr (Epi::MID) { if (t == nt / 2 - 2) { PG8_SCHED; E.mid(acc, cur, wr, wc, fr, fq); PG8_SCHED; } }
        }
        if constexpr (ALIGN_EPI) { if (wr == 0) PG8_BAR; }
        if constexpr (!Epi::AFTER_DRAIN) { E(acc, cur, wr, wc, fr, fq); S.done(cur); }
        if (!has_next) break;
#pragma unroll
        for (int a = 0; a < 2; ++a)
#pragma unroll
            for (int b = 0; b < 2; ++b)
#pragma unroll
                for (int m = 0; m < 4; ++m)
#pragma unroll
                    for (int n = 0; n < 2; ++n) acc[a][b][m][n] = (f32x4){0.f, 0.f, 0.f, 0.f};
        cur = nxt; cA = nA; cB = nB; ++ui;
        if constexpr (ALIGN_EPI) { if (wr == 1) PG8_BAR; }
    }
    PG8_WAIT_V(0);
    if constexpr (!ALIGN_EPI) { if (wr == 0) PG8_BAR; }
    PG8_BAR;
    if constexpr (Epi::AFTER_DRAIN) { E.fused(acc, cur, wr, wc, fr, fq, lds, wid, lane); S.done(cur); }
#undef PG8_SA
#undef PG8_SB
#undef PG8_STAGE
#undef PG8_LDA
#undef PG8_LDB
#undef PG8_MMA
#undef PG8_WAIT_V
#undef PG8_WAIT_L
#undef PG8_BAR
#undef PG8_SCHED
}
}
namespace att {
typedef unsigned short bf16;
using bf16x8 = __attribute__((ext_vector_type(8))) short;
using s16x4  = __attribute__((ext_vector_type(4))) short;
using f32x16 = __attribute__((ext_vector_type(16))) float;
using u32x4  = __attribute__((ext_vector_type(4))) unsigned;
using f32x2  = __attribute__((ext_vector_type(2))) float;
constexpr int NW = 8, QBLK = 32, KVBLK = 64;
constexpr int SHM_V = KVBLK * 128 * 2, SHM_K = KVBLK * 128 * 2, SHM_KR = KVBLK * 64 * 2;
constexpr int O3_V = 0, O3_K = 3 * SHM_V, O3_KR = O3_K + 3 * SHM_K, O3_WS = O3_KR + 3 * SHM_KR, O3_QR = O3_WS + NW * 64 * 4, ATT3_LDS = O3_QR + NW * 4096;
#define KSWZ(row, colB) ((row) * 256 + ((colB) ^ (((row) & 15) << 4)))
#define KRSWZ(row, colB) ((row) * 128 + ((colB) ^ ((((row) >> 1) & 7) << 4)))
#define SBAR() __builtin_amdgcn_sched_barrier(0)
__device__ __forceinline__ int crow(int r, int hi) { return (r & 3) + 8 * (r >> 2) + 4 * hi; }
typedef __bf16 bf16x2_t __attribute__((ext_vector_type(2)));
__device__ __forceinline__ unsigned cvtpk(float lo, float hi) { const float __attribute__((ext_vector_type(2))) v = {lo, hi}; return __builtin_bit_cast(unsigned, __builtin_convertvector(v, bf16x2_t)); }

template <bool MASK> __device__ __forceinline__ void partialSM(f32x16& p0, f32x16& p1, float& m_reg, float& mn, float& alpha, const float C, const float THRR, int qi, int kb, int hi) {
  if (MASK) {
    int t = qi - 128 - kb - 4 * hi; asm volatile("" : "+v"(t));
#pragma unroll
    for (int r = 0; r < 16; ++r) { const int cr = (r & 3) + 8 * (r >> 2);
      p0[r] = ((unsigned)(cr - t) <= 256u) ? p0[r] : -__builtin_inff();
      p1[r] = ((unsigned)(cr + 32 - t) <= 256u) ? p1[r] : -__builtin_inff(); }
  }
  float pmax = p0[0];
#pragma unroll
  for (int r = 1; r < 16; ++r) pmax = fmaxf(pmax, p0[r]);
#pragma unroll
  for (int r = 0; r < 16; ++r) pmax = fmaxf(pmax, p1[r]);
  { auto rr = __builtin_amdgcn_permlane32_swap(__float_as_uint(pmax), __float_as_uint(pmax), false, false);
    pmax = fmaxf(__uint_as_float(rr[0]), __uint_as_float(rr[1])); }
  if (__builtin_expect(__all(pmax - m_reg <= THRR), 1)) { mn = m_reg; alpha = 1.f; }
  else { mn = fmaxf(m_reg, pmax); alpha = __builtin_amdgcn_exp2f((m_reg - mn) * C); m_reg = mn; }
  const float mnC = -mn * C; const f32x2 C2 = {C, C}, mnC2 = {mnC, mnC};
#pragma unroll
  for (int r = 0; r < 16; r += 2) { const f32x2 t = __builtin_elementwise_fma((f32x2){p0[r], p0[r + 1]}, C2, mnC2); p0[r] = t.x; p0[r + 1] = t.y; }
#pragma unroll
  for (int r = 0; r < 16; r += 2) { const f32x2 t = __builtin_elementwise_fma((f32x2){p1[r], p1[r + 1]}, C2, mnC2); p1[r] = t.x; p1[r + 1] = t.y; }
#pragma unroll
  for (int r = 0; r < 16; ++r) p0[r] = __builtin_amdgcn_exp2f(p0[r]);
}
__device__ __forceinline__ void finishSM(f32x16& p0, f32x16& p1, float alpha, float& l_reg, bf16x8& pa0, bf16x8& pa1, bf16x8& pa2, bf16x8& pa3) {
#pragma unroll
  for (int r = 0; r < 16; ++r) p1[r] = __builtin_amdgcn_exp2f(p1[r]);
  f32x2 ps2 = {p0[0], p0[1]};
#pragma unroll
  for (int r = 2; r < 16; r += 2) ps2 += (f32x2){p0[r], p0[r + 1]};
#pragma unroll
  for (int r = 0; r < 16; r += 2) ps2 += (f32x2){p1[r], p1[r + 1]};
  float ps = ps2.x + ps2.y;
  { auto rr = __builtin_amdgcn_permlane32_swap(__float_as_uint(ps), __float_as_uint(ps), false, false);
    ps = __uint_as_float(rr[0]) + __uint_as_float(rr[1]); }
  l_reg = l_reg * alpha + ps;
#define PK4(P, BASE, OUT) do { unsigned a0 = cvtpk(P[BASE + 0], P[BASE + 1]), a1 = cvtpk(P[BASE + 2], P[BASE + 3]);   \
    unsigned b0 = cvtpk(P[BASE + 4], P[BASE + 5]), b1 = cvtpk(P[BASE + 6], P[BASE + 7]);                              \
    auto r0 = __builtin_amdgcn_permlane32_swap(a0, b0, false, false); auto r1 = __builtin_amdgcn_permlane32_swap(a1, b1, false, false); \
    u32x4 w = {r0[0], r1[0], r0[1], r1[1]}; OUT = *reinterpret_cast<bf16x8*>(&w); } while (0)
  PK4(p0, 0, pa0); PK4(p0, 8, pa1); PK4(p1, 0, pa2); PK4(p1, 8, pa3);
#undef PK4
}
template <int NR> __device__ __forceinline__ void qkt(f32x16& p0, f32x16& p1, const char* Ks, const char* KRs, const bf16x8* qr, const char* qrl, int r32, int hi) {
  p0 = f32x16{}; p1 = f32x16{};
#pragma unroll
  for (int d0 = 0; d0 < 8; ++d0) { const int cb = (d0 * 16 + hi * 8) * 2;
    const bf16x8 b0 = *reinterpret_cast<const bf16x8*>(Ks + KSWZ(r32, cb));
    const bf16x8 b1 = *reinterpret_cast<const bf16x8*>(Ks + KSWZ(32 + r32, cb));
    p0 = __builtin_amdgcn_mfma_f32_32x32x16_bf16(b0, qr[d0], p0, 0, 0, 0);
    p1 = __builtin_amdgcn_mfma_f32_32x32x16_bf16(b1, qr[d0], p1, 0, 0, 0); }
#pragma unroll
  for (int d0 = 0; d0 < NR; ++d0) { const int cb = (d0 * 16 + hi * 8) * 2;
    const bf16x8 b0 = *reinterpret_cast<const bf16x8*>(KRs + KRSWZ(r32, cb));
    const bf16x8 b1 = *reinterpret_cast<const bf16x8*>(KRs + KRSWZ(32 + r32, cb));
    const bf16x8 qf = *reinterpret_cast<const bf16x8*>(qrl + d0 * 1024);
    p0 = __builtin_amdgcn_mfma_f32_32x32x16_bf16(b0, qf, p0, 0, 0, 0);
    p1 = __builtin_amdgcn_mfma_f32_32x32x16_bf16(b1, qf, p1, 0, 0, 0); }
}
__device__ __forceinline__ int v_st(int k, int c) { const int kk = (k & ~0xC) | ((k & 4) << 1) | ((k & 8) >> 1); return ((kk >> 3) * 4 + (c >> 5)) * 512 + ((kk & 7) * 32 + (c & 31)) * 2; }
__device__ __forceinline__ int v_rd_base(int lane) { return ((lane & 3) << 3) | (((lane >> 2) & 3) << 6) | (((lane >> 4) & 1) << 5) | (((lane >> 5) & 1) << 8); }
constexpr int v_rd_off(int d0, int ks, int half) { return d0 * 512 + ks * 4096 + half * 2048; }
template <int OFF> __device__ __forceinline__ s16x4 tr_read(int vb) { s16x4 r; asm volatile("ds_read_b64_tr_b16 %0, %1 offset:%2" : "=&v"(r) : "v"(vb), "i"(OFF) : "memory"); return r; }
template <int D0> __device__ __forceinline__ void pv_one(f32x16& od, int vb, bf16x8 pa0, bf16x8 pa1, bf16x8 pa2, bf16x8 pa3) {
  const s16x4 l0 = tr_read<v_rd_off(D0, 0, 0)>(vb), h0 = tr_read<v_rd_off(D0, 0, 1)>(vb), l1 = tr_read<v_rd_off(D0, 1, 0)>(vb), h1 = tr_read<v_rd_off(D0, 1, 1)>(vb);
  const s16x4 l2 = tr_read<v_rd_off(D0, 2, 0)>(vb), h2 = tr_read<v_rd_off(D0, 2, 1)>(vb), l3 = tr_read<v_rd_off(D0, 3, 0)>(vb), h3 = tr_read<v_rd_off(D0, 3, 1)>(vb);
  asm volatile("s_waitcnt lgkmcnt(0)" ::: "memory"); SBAR();
#define PK(L, H) (bf16x8){L[0], L[1], L[2], L[3], H[0], H[1], H[2], H[3]}
  od = __builtin_amdgcn_mfma_f32_32x32x16_bf16(pa0, PK(l0, h0), od, 0, 0, 0);
  od = __builtin_amdgcn_mfma_f32_32x32x16_bf16(pa1, PK(l1, h1), od, 0, 0, 0);
  od = __builtin_amdgcn_mfma_f32_32x32x16_bf16(pa2, PK(l2, h2), od, 0, 0, 0);
  od = __builtin_amdgcn_mfma_f32_32x32x16_bf16(pa3, PK(l3, h3), od, 0, 0, 0);
#undef PK
}
__device__ __forceinline__ void pv_d0(f32x16* o, int vb, bf16x8 pa0, bf16x8 pa1, bf16x8 pa2, bf16x8 pa3) {
  pv_one<0>(o[0], vb, pa0, pa1, pa2, pa3); pv_one<1>(o[1], vb, pa0, pa1, pa2, pa3); pv_one<2>(o[2], vb, pa0, pa1, pa2, pa3); pv_one<3>(o[3], vb, pa0, pa1, pa2, pa3);
}

__device__ __forceinline__ void glds16(const void* gsrc, unsigned lds_dst) {
  unsigned keep; asm volatile("s_mov_b32 %0, m0\n\ts_mov_b32 m0, %2\n\ts_nop 0\n\tglobal_load_lds_dwordx4 %1, off\n\ts_mov_b32 m0, %0" : "=&s"(keep) : "v"(gsrc), "s"(lds_dst) : "memory"); }
template <bool MLA, int LDQ, int LDQR, int LDK>
__device__ __forceinline__ void attn_body_dma(const bf16* Qb, const bf16* Qrb, const bf16* __restrict__ Kh, const bf16* __restrict__ Vh, const bf16* __restrict__ KRh,
                                              bf16* Ob, int NT, const float C, const float THRR, const float m0, const float l0, int q0, int kb0, char* lds, const int wave_s) {
  constexpr int NR = MLA ? 4 : 0;
  int tid_ = wave_s * 64 + lane_id_fresh(); asm volatile("" : "+v"(tid_));
  const int tid = tid_, wid = tid >> 6, lane = tid & 63, r32 = lane & 31, hi = lane >> 5;
  char* V_lds = lds + O3_V; char* K_lds = lds + O3_K; char* KR_lds = lds + O3_KR;
  float* wsf = (float*)(lds + O3_WS) + wid * 64; float* li_l = wsf; float* al_l = wsf + 32;
  float m_reg = m0, l_reg = l0; f32x16 o[4] = {}; bf16x8 qr[8];
  const bf16* Qw = Qb + (long)(wid * QBLK + r32) * LDQ + hi * 8;
#pragma unroll
  for (int d0 = 0; d0 < 8; ++d0) qr[d0] = *reinterpret_cast<const bf16x8*>(Qw + d0 * 16);
  const char* qrl = lds + O3_QR + wid * 4096 + lane * 16;
  if (MLA) { const bf16* Qrw = Qrb + (long)(wid * QBLK + r32) * LDQR + hi * 8;
#pragma unroll
    for (int d0 = 0; d0 < NR; ++d0) *(bf16x8*)(lds + O3_QR + wid * 4096 + lane * 16 + d0 * 1024) = *reinterpret_cast<const bf16x8*>(Qrw + d0 * 16); }
  const int qi = q0 + wid * QBLK + r32;
  const int vb0 = (int)(uintptr_t)V_lds + v_rd_base(lane);
  unsigned offK[2], offV[2], offKR;
#pragma unroll
  for (int i = 0; i < 2; ++i) { const int B = (2 * wid + i) * 1024 + 16 * lane;
    { const int row = B >> 8, pc = (B >> 4) & 15; offK[i] = (unsigned)(row * LDK * 2 + ((pc ^ (row & 15)) << 4)); }
    { const int s_ = B >> 9, o_ = B & 511, kk = (s_ >> 2) * 8 + (o_ >> 6), c = (s_ & 3) * 32 + ((o_ & 63) >> 1), k = (kk & ~0xC) | ((kk & 4) << 1) | ((kk & 8) >> 1);
      offV[i] = (unsigned)(k * LDK * 2 + c * 2); } }
  { const int B = wid * 1024 + 16 * lane, row = B >> 7, pc = (B >> 4) & 7; offKR = (unsigned)(row * 128 + ((pc ^ ((row >> 1) & 7)) << 4)); }
  const unsigned ldsb = (unsigned)__builtin_amdgcn_readfirstlane((int)(uintptr_t)lds);
  const unsigned ldsV = ldsb + O3_V + 2 * wave_s * 1024, ldsK = ldsb + O3_K + 2 * wave_s * 1024, ldsKR = ldsb + O3_KR + wave_s * 1024;
#define DMA_TILE(t, b) do { const size_t tb_ = (size_t)(t) * (KVBLK * LDK * 2); \
    glds16((const char*)Kh + tb_ + offK[0], ldsK + (b) * SHM_K); glds16((const char*)Kh + tb_ + offK[1], ldsK + (b) * SHM_K + 1024); \
    glds16((const char*)Vh + tb_ + offV[0], ldsV + (b) * SHM_V); glds16((const char*)Vh + tb_ + offV[1], ldsV + (b) * SHM_V + 1024); \
    if (MLA) glds16((const char*)KRh + (size_t)(t) * (KVBLK * 128) + offKR, ldsKR + (b) * SHM_KR); } while (0)
#define PUBLISH() asm volatile("s_waitcnt vmcnt(0)\n\ts_barrier" ::: "memory")
#define RESC3(a) do { if (__any((a) < 1.f)) { if (hi == 0) al_l[r32] = (a); asm volatile("s_waitcnt lgkmcnt(0)" ::: "memory"); \
    _Pragma("unroll") for (int d = 0; d < 4; ++d) _Pragma("unroll") for (int r = 0; r < 16; ++r) o[d][r] *= al_l[crow(r, hi)]; } } while (0)
  f32x16 pA0, pA1, pB0, pB1; float mnA, mnB, alA, alB; bf16x8 pa0, pa1, pa2, pa3;
  DMA_TILE(0, 0); DMA_TILE(1, 1); asm volatile("s_waitcnt lgkmcnt(0)" ::: "memory"); PUBLISH();
  qkt<NR>(pA0, pA1, K_lds, KR_lds, qr, qrl, r32, hi); partialSM<!MLA>(pA0, pA1, m_reg, mnA, alA, C, THRR, qi, kb0, hi);
  int bprev = 0, bcur = 1, bnext = 2;
#define ROT3() do { const int t_ = bprev; bprev = bcur; bcur = bnext; bnext = t_; } while (0)
  for (int j = 1; j + 1 < NT; j += 2) {
    DMA_TILE(j + 1, bnext);
    SBAR(); qkt<NR>(pB0, pB1, K_lds + bcur * SHM_K, KR_lds + bcur * SHM_KR, qr, qrl, r32, hi);
    finishSM(pA0, pA1, alA, l_reg, pa0, pa1, pa2, pa3); SBAR();
    pv_d0(o, vb0 + bprev * SHM_V, pa0, pa1, pa2, pa3); partialSM<!MLA>(pB0, pB1, m_reg, mnB, alB, C, THRR, qi, kb0 + j * KVBLK, hi);
    RESC3(alB); PUBLISH(); ROT3();
    DMA_TILE(j + 2, bnext);
    SBAR(); qkt<NR>(pA0, pA1, K_lds + bcur * SHM_K, KR_lds + bcur * SHM_KR, qr, qrl, r32, hi);
    finishSM(pB0, pB1, alB, l_reg, pa0, pa1, pa2, pa3); SBAR();
    pv_d0(o, vb0 + bprev * SHM_V, pa0, pa1, pa2, pa3); partialSM<!MLA>(pA0, pA1, m_reg, mnA, alA, C, THRR, qi, kb0 + (j + 1) * KVBLK, hi);
    RESC3(alA); PUBLISH(); ROT3();
  }
  SBAR(); qkt<NR>(pB0, pB1, K_lds + bcur * SHM_K, KR_lds + bcur * SHM_KR, qr, qrl, r32, hi);
  finishSM(pA0, pA1, alA, l_reg, pa0, pa1, pa2, pa3); SBAR();
  pv_d0(o, vb0 + bprev * SHM_V, pa0, pa1, pa2, pa3); partialSM<!MLA>(pB0, pB1, m_reg, mnB, alB, C, THRR, qi, kb0 + (NT - 1) * KVBLK, hi);
  RESC3(alB);
  finishSM(pB0, pB1, alB, l_reg, pa0, pa1, pa2, pa3); SBAR();
  pv_d0(o, vb0 + bcur * SHM_V, pa0, pa1, pa2, pa3);
  if (hi == 0) li_l[r32] = l_reg; asm volatile("s_waitcnt lgkmcnt(0)" ::: "memory");
  float rli[16];
#pragma unroll
  for (int r = 0; r < 16; ++r) rli[r] = __builtin_amdgcn_rcpf(li_l[crow(r, hi)]);
  bf16* Ow = Ob + (long)(wid * QBLK) * LDQ;
#pragma unroll
  for (int r = 0; r < 16; ++r) { const int orow = crow(r, hi);
#pragma unroll
    for (int d0 = 0; d0 < 4; ++d0) { const float v = o[d0][r] * rli[r]; Ow[(long)orow * LDQ + d0 * 32 + r32] = (bf16)(cvtpk(v, v) & 0xffffu); } }
  asm volatile("s_waitcnt vmcnt(0) lgkmcnt(0)\n\ts_barrier" ::: "memory");
#undef DMA_TILE
#undef PUBLISH
#undef RESC3
#undef ROT3
}
#undef KSWZ
#undef KRSWZ
#undef SBAR
}
constexpr int NWAVES = 8;
constexpr int NB = 8, SEQ = 4096, M = NB * SEQ, D = 2048, FF = 5632, DEPTH = 2, NMOD = 9 * D, WIN_SRC = 6720, WIN_N = 6912;
constexpr float EPS = 1e-6f;
constexpr size_t MiB = 1u << 20;
constexpr size_t WS_CTL = 0, WS_MOD = 1 * MiB, WS_SS = 2 * MiB + 256 * 1024  , WS_ZERO_BYTES = 3 * MiB;
constexpr size_t WS_COSA = 4 * MiB, WS_SINA = 12 * MiB, WS_COSR = 20 * MiB, WS_SINR = 24 * MiB;
constexpr size_t WS_W = 28 * MiB;
constexpr size_t LW_GU1 = 0, LW_D1 = LW_GU1 + (size_t)2 * FF * D, LW_GU2 = LW_D1 + (size_t)FF * D, LW_D2 = LW_GU2 + (size_t)2 * FF * D, LW_IN = LW_D2 + (size_t)FF * D,
                 LW_UQ = LW_IN + (size_t)WIN_N * D, LW_UKV = LW_UQ + (size_t)1536 * 512, LW_OA = LW_UKV + (size_t)2048 * 512, LW_OB = LW_OA + (size_t)2048 * 1024,
                 LW_OUT = LW_OB + (size_t)2048 * 1024, LW_ELEMS = LW_OUT + (size_t)2048 * 2048;
static_assert(LW_ELEMS == 93585408, "weight map");
constexpr size_t WS_X16 = WS_W + ((2 * LW_ELEMS * 2 + MiB - 1) / MiB) * MiB;
constexpr size_t WS_BIG = WS_X16 + 128 * MiB;
constexpr size_t B_QA = 0  ,
                 B_KA = 128 * MiB, B_VA = 144 * MiB, B_CQN = 160 * MiB, B_CKVN = 192 * MiB, B_KR = 224 * MiB, B_GATES = 232 * MiB, B_QBR = 488 * MiB, B_KVB = 520 * MiB, B_END = 648 * MiB;
constexpr size_t B_ACT = 0, B_DELTA = 352 * MiB  ;
constexpr size_t WS_END = WS_BIG + B_END;
static_assert((size_t)M * FF * 2 <= B_END && WS_X16 == 385 * MiB, "d_ws map");
constexpr int CW_BAR = 4096;
constexpr int LDS_BYTES = 163840, LDSCTL_OFF = 162816, SCR_OFF = 65536, SCR_WAVE = 8448;
static_assert(SCR_OFF + NWAVES * SCR_WAVE <= LDSCTL_OFF && att::ATT3_LDS <= LDSCTL_OFF, "LDS map");

#define GAS __attribute__((address_space(1)))
#define LAS __attribute__((address_space(3)))
typedef unsigned short bf16;
typedef unsigned v4u __attribute__((ext_vector_type(4)));
typedef unsigned v2u __attribute__((ext_vector_type(2)));
typedef float f32x4 __attribute__((ext_vector_type(4)));
typedef _Float16 h16x4 __attribute__((ext_vector_type(4)));
#define LDS_WAIT() asm volatile("s_waitcnt lgkmcnt(0)" ::: "memory")
#define VM_WAIT() asm volatile("s_waitcnt vmcnt(0)" ::: "memory")
__device__ __forceinline__ unsigned f2bf(float f) { unsigned u = __builtin_bit_cast(unsigned, f); return (u + 0x7fffu + ((u >> 16) & 1u)) >> 16; }
__device__ __forceinline__ unsigned pk2(float lo, float hi) { return f2bf(lo) | (f2bf(hi) << 16); }
template <int CTRL> __device__ __forceinline__ float dpp_add(float v) { return v + __int_as_float(__builtin_amdgcn_update_dpp(0, __float_as_int(v), CTRL, 0xf, 0xf, true)); }
__device__ __forceinline__ float wave_sum(float v) {
    v = dpp_add<0xB1>(v);
    v = dpp_add<0x4E>(v);
    v = dpp_add<0x141>(v);
    v = dpp_add<0x140>(v);
    { auto r = __builtin_amdgcn_permlane16_swap(__float_as_uint(v), __float_as_uint(v), false, false); v = __uint_as_float(r[0]) + __uint_as_float(r[1]); }
    { auto r = __builtin_amdgcn_permlane32_swap(__float_as_uint(v), __float_as_uint(v), false, false); v = __uint_as_float(r[0]) + __uint_as_float(r[1]); }
    return v;
}
#define XB_TMO      128
#define XB_XCNT(j)  (256  + 64 * (j))
#define XB_XSUB(j)  (1280 + 64 * (j))
#define XB_XGEN(j)  (2304 + 64 * (j))
#define XB_TOP      3328
#define XB_TOPGEN   3392
#define XCD_BAR_WORDS 3456
#define XB_SPIN_CAP (1u << 18)

__device__ __forceinline__ unsigned xb_ld(unsigned* p)              { return __hip_atomic_load(p, __ATOMIC_RELAXED, __HIP_MEMORY_SCOPE_AGENT); }
__device__ __forceinline__ unsigned xb_add(unsigned* p, unsigned v) { return __hip_atomic_fetch_add(p, v, __ATOMIC_RELAXED, __HIP_MEMORY_SCOPE_AGENT); }
__device__ __forceinline__ unsigned xb_xcc_id() { return (unsigned)__builtin_amdgcn_s_getreg((3 << 11) | 20) & 0xFu; }
#define XB_SPIN(cond, bar) do { unsigned _sp = 0; while (cond) { __builtin_amdgcn_s_sleep(1); \
    if ((++_sp & 255u) == 0u) { if (xb_ld(&(bar)[XB_TMO])) break; if (_sp > XB_SPIN_CAP) { atomicAdd(&(bar)[XB_TMO], 1u); break; } } } } while (0)

struct XcdBarrier {
    unsigned* bar; unsigned x;
    unsigned wv;
    volatile LAS unsigned* st;
};

__device__ __forceinline__ XcdBarrier xcd_barrier_post(unsigned* bar, volatile LAS unsigned* st) {
    XcdBarrier b; b.bar = bar; b.x = xb_xcc_id(); b.st = st; b.wv = (unsigned)__builtin_amdgcn_readfirstlane(threadIdx.x >> 6);
    if (threadIdx.x == 0) (void)xb_add(&bar[XB_XCNT(b.x)], 1u);
    return b;
}
__device__ __forceinline__ void xcd_barrier_complete(unsigned* bar, unsigned x, unsigned& nloc, unsigned& nx) {
    const unsigned G = gridDim.x * gridDim.y * gridDim.z;
    unsigned sum, cnt, mine, sp = 0u;
    for (;;) {
        sum = 0u; cnt = 0u; mine = 0u;
#pragma unroll
        for (unsigned j = 0; j < 16; ++j) { const unsigned c = xb_ld(&bar[XB_XCNT(j)]); sum += c; cnt += (c > 0u) ? 1u : 0u; mine = (j == x) ? c : mine; }
        if (sum == G) break;
        __builtin_amdgcn_s_sleep(1);
        if ((++sp & 255u) == 0u) { if (xb_ld(&bar[XB_TMO])) break; if (sp > XB_SPIN_CAP) { atomicAdd(&bar[XB_TMO], 1u); break; } }
    }
    nloc = mine > 0u ? mine : 1u; nx = cnt > 0u ? cnt : 1u;
}

__device__ __forceinline__ void xcd_barrier(const XcdBarrier& b) {
    asm volatile("s_waitcnt vmcnt(0)" ::: "memory");
    __syncthreads();
    if (b.wv == 0u && lane_id_fresh() == 0) {
        unsigned* bar = b.bar;
        __builtin_amdgcn_s_waitcnt(0);
        unsigned nloc = b.st[0], nx = b.st[1];
        if (nloc == 0u) { xcd_barrier_complete(bar, b.x, nloc, nx); b.st[0] = nloc; b.st[1] = nx; }
        const unsigned old = xb_add(&bar[XB_XSUB(b.x)], 1u);
        const unsigned gen = old / nloc;
        if (old + 1u == (gen + 1u) * nloc) {
            __builtin_amdgcn_fence(__ATOMIC_RELEASE, "agent");
            asm volatile("s_waitcnt vmcnt(0)" ::: "memory");
            const unsigned og = xb_add(&bar[XB_TOP], 1u);
            const unsigned tg = og / nx;
            if (og + 1u == (tg + 1u) * nx) xb_add(&bar[XB_TOPGEN], 1u);
            else XB_SPIN(xb_ld(&bar[XB_TOPGEN]) == tg, bar);
            __builtin_amdgcn_fence(__ATOMIC_ACQUIRE, "agent");
            xb_add(&bar[XB_XGEN(b.x)], 1u);
            asm volatile("s_waitcnt vmcnt(0)" ::: "memory");
        } else {
            XB_SPIN(xb_ld(&bar[XB_XGEN(b.x)]) == gen, bar);
            __builtin_amdgcn_fence(__ATOMIC_ACQUIRE, "agent");
            asm volatile("s_waitcnt vmcnt(0)" ::: "memory");
        }
    }
    __syncthreads();
}
#define LOCAL_IDS() int tid_ = wave_s * 64 + lane_id_fresh(); asm volatile("" : "+v"(tid_)); const int lane = tid_ & 63, gw = vcu * NWAVES + __builtin_amdgcn_readfirstlane(tid_ >> 6), NGW = G * NWAVES
__device__ __forceinline__ int map_col(int map, int n) {
    if (map == 0) return n;
    if (map == 1) { const int t = n >> 8, j = n & 255; return j < 128 ? 128 * t + j : FF + 128 * t + (j - 128); }
    if (map == 2) {
        const int t = n >> 8, j = n & 255, bj = j >> 7, jj = j & 127;
        if (t < 4) return (2 * t + (jj >> 6)) * 128 + (jj & 63) + 64 * bj;
        if (t == 4) return 1024 + (jj >> 6) * 128 + (jj & 63) + 64 * bj;
        if (t == 5) return 1280 + j;
        if (t < 10) return 1536 + (t - 6) * 256 + j;
        if (t == 10) return jj < 32 ? 2560 + bj * 32 + jj : -1;
        return 2624 + (t - 11) * 256 + j;
    }
    {
        if (n < 1024) return (n >> 7) * 192 + (n & 127);
        const int t = (n >> 8) - 4, j = n & 255, bj = j >> 7, jj = j & 127;
        return (4 * t + (jj >> 5)) * 192 + 128 + (jj & 31) + 32 * bj;
    }
}
__device__ __forceinline__ void tr_item(const float* W, int K, int Nsrc, int Ndst, bf16* WT, int map, LAS float* scr, int item, int lane, int ldt = 0) {
    const int nblk = Ndst >> 5, kb = item / nblk, nb = item - kb * nblk, k0 = 64 * kb, n0 = 32 * nb;
    const int src = map_col(map, n0 + (lane & 31));
    const float* wp = W + (size_t)(k0 + (lane >> 5)) * Nsrc + (src < 0 ? 0 : src);
    float tv[32];
#pragma unroll
    for (int i = 0; i < 32; ++i) tv[i] = wp[(size_t)(2 * i) * Nsrc];
#pragma unroll
    for (int i = 0; i < 32; ++i) scr[(2 * i + (lane >> 5)) * 33 + (lane & 31)] = src < 0 ? 0.f : tv[i];
    LDS_WAIT(); asm volatile("" ::: "memory");
    const int c = lane & 7;
#pragma unroll
    for (int j = 0; j < 4; ++j) { const int n = (lane >> 3) + 8 * j; const LAS float* s = scr + (8 * c) * 33 + n;
        v4u o; o.x = pk2(s[0 * 33], s[1 * 33]); o.y = pk2(s[2 * 33], s[3 * 33]); o.z = pk2(s[4 * 33], s[5 * 33]); o.w = pk2(s[6 * 33], s[7 * 33]);
        *(v4u*)(WT + (size_t)(n0 + n) * (ldt ? ldt : K) + k0 + 8 * c) = o; }
    LDS_WAIT(); asm volatile("" ::: "memory");
}
__device__ __forceinline__ void sincos_d(float angf, float& s_out, float& c_out) {
    const double a = (double)angf;
    const double q = __builtin_rint(a * 0.63661977236758134308);
    double t = __builtin_fma(-q, 1.57079632679489655800, a); t = __builtin_fma(-q, 6.12323399573676603587e-17, t);
    const double t2 = t * t;
    double sp = 1.0 / 6227020800.0; sp = sp * t2 - 1.0 / 39916800.0; sp = sp * t2 + 1.0 / 362880.0; sp = sp * t2 - 1.0 / 5040.0; sp = sp * t2 + 1.0 / 120.0; sp = sp * t2 - 1.0 / 6.0; sp = sp * t2 + 1.0; sp = sp * t;
    double cp = -1.0 / 87178291200.0; cp = cp * t2 + 1.0 / 479001600.0; cp = cp * t2 - 1.0 / 3628800.0; cp = cp * t2 + 1.0 / 40320.0; cp = cp * t2 - 1.0 / 720.0; cp = cp * t2 + 1.0 / 24.0; cp = cp * t2 - 0.5; cp = cp * t2 + 1.0;
    const int qi = ((int)(long long)q) & 3;
    const double s = (qi == 0) ? sp : (qi == 1) ? cp : (qi == 2) ? -sp : -cp;
    const double c = (qi == 0) ? cp : (qi == 1) ? -sp : (qi == 2) ? -cp : sp;
    s_out = (float)s; c_out = (float)c;
}

struct P {
    const float *x, *c, *norm_g, *w_ada, *b_ada, *w_gu1, *w_d1, *w_gu2, *w_d2, *w_in, *b_gate, *sink, *g_cq, *g_ckv, *w_uq, *w_ukv, *w_oa, *w_ob, *w_out, *g_final;
    const int* pos; float* out; unsigned char* ws;
};

__device__ __forceinline__ void prologue(const P& p, LAS unsigned char* lds, int vcu, int G, const bool skip_ada, const int wave_s) {
    LOCAL_IDS(); const int tid = tid_, wave = __builtin_amdgcn_readfirstlane(tid_ >> 6);
    LAS float* cact = (LAS float*)lds;
    for (int i = tid; i < NB * D; i += NWAVES * 64) { const int b = i >> 11, k = i & 2047; const float cv = p.c[i]; cact[k * 8 + b] = cv / (1.0f + expf(-cv)); }
    __syncthreads();
    LAS float* scr = (LAS float*)(lds + SCR_OFF + wave * SCR_WAVE);
    float* mod = (float*)(p.ws + WS_MOD);
    constexpr int I_ADA = DEPTH * 72 * 8, I_TAB = M / 16;
    constexpr int I_GU = 32 * 352, I_D = 88 * 64, I_IN = 32 * (WIN_N / 32), I_UQ = 8 * 48, I_UKV = 8 * 64, I_O = 16 * 64, I_OUT = 32 * 64;
    constexpr int I_LAYER = 2 * I_GU + 2 * I_D + I_IN + I_UQ + I_UKV + 2 * I_O + I_OUT;
    constexpr int NITEMS = I_ADA + I_TAB + DEPTH * I_LAYER;
    for (int it = gw; it < NITEMS; it += NGW) {
        int r = it;
        if (r < I_ADA) { if (skip_ada) continue;
            const int l = r / 576, rr = r - l * 576, cg = rr >> 3, kc = rr & 7;
            const float* W = p.w_ada + ((size_t)l * D + 256 * kc) * NMOD + 256 * cg + 4 * lane;
            f32x4 acc[8];
#pragma unroll
            for (int b = 0; b < 8; ++b) acc[b] = (f32x4){0.f, 0.f, 0.f, 0.f};
            for (int k = 0; k < 256; k += 16) {
                f32x4 w[16];
#pragma unroll
                for (int kk = 0; kk < 16; ++kk) w[kk] = *(const f32x4*)(W + (size_t)(k + kk) * NMOD);
#pragma unroll
                for (int kk = 0; kk < 16; ++kk) { const LAS f32x4* cp = (const LAS f32x4*)(cact + (256 * kc + k + kk) * 8); const f32x4 c0 = cp[0], c1 = cp[1];
                    acc[0] += w[kk] * c0[0]; acc[1] += w[kk] * c0[1]; acc[2] += w[kk] * c0[2]; acc[3] += w[kk] * c0[3];
                    acc[4] += w[kk] * c1[0]; acc[5] += w[kk] * c1[1]; acc[6] += w[kk] * c1[2]; acc[7] += w[kk] * c1[3]; }
            }
            if (kc == 0) { const f32x4 bv = *(const f32x4*)(p.b_ada + (size_t)l * NMOD + 256 * cg + 4 * lane);
#pragma unroll
                for (int b = 0; b < 8; ++b) acc[b] += bv; }
#pragma unroll
            for (int b = 0; b < 8; ++b) { float* dst = mod + (size_t)(l * 8 + b) * NMOD + 256 * cg + 4 * lane;
#pragma unroll
                for (int i = 0; i < 4; ++i) unsafeAtomicAdd(dst + i, acc[b][i]); }
            continue;
        }
        r -= I_ADA;
        if (r < I_TAB) {
            const double ea = -(double)lane * (1.0 / 64.0), er = -(double)(lane & 31) * (1.0 / 32.0);
            const float fa = (float)exp2(ea * 13.287712379549449), fr = (float)exp2(er * 13.287712379549449);
            float* cosA = (float*)(p.ws + WS_COSA); float* sinA = (float*)(p.ws + WS_SINA); float* cosR = (float*)(p.ws + WS_COSR); float* sinR = (float*)(p.ws + WS_SINR);
            for (int i = 0; i < 16; ++i) { const int m = 16 * r + i; const float pf = (float)p.pos[m];
                float s, c; sincos_d(pf * fa, s, c); cosA[(size_t)m * 64 + lane] = c; sinA[(size_t)m * 64 + lane] = s;
                if (lane < 32) { sincos_d(pf * fr, s, c); cosR[(size_t)m * 32 + lane] = c; sinR[(size_t)m * 32 + lane] = s; } }
            continue;
        }
        r -= I_TAB;
        const int l = r >= I_LAYER ? 1 : 0; r -= l * I_LAYER;
        bf16* wl = (bf16*)(p.ws + WS_W) + (size_t)l * LW_ELEMS;
        if (r < I_GU) { tr_item(p.w_gu1 + (size_t)l * D * 2 * FF, D, 2 * FF, 2 * FF, wl + LW_GU1, 1, scr, r, lane); continue; } r -= I_GU;
        if (r < I_D)  { tr_item(p.w_d1 + (size_t)l * FF * D, FF, D, D, wl + LW_D1, 0, scr, r, lane); continue; } r -= I_D;
        if (r < I_GU) { tr_item(p.w_gu2 + (size_t)l * D * 2 * FF, D, 2 * FF, 2 * FF, wl + LW_GU2, 1, scr, r, lane); continue; } r -= I_GU;
        if (r < I_D)  { tr_item(p.w_d2 + (size_t)l * FF * D, FF, D, D, wl + LW_D2, 0, scr, r, lane); continue; } r -= I_D;
        if (r < I_IN) { tr_item(p.w_in + (size_t)l * D * WIN_SRC, D, WIN_SRC, WIN_N, wl + LW_IN, 2, scr, r, lane); continue; } r -= I_IN;
        if (r < I_UQ) { tr_item(p.w_uq + (size_t)l * 512 * 1536, 512, 1536, 1536, wl + LW_UQ, 3, scr, r, lane); continue; } r -= I_UQ;
        if (r < I_UKV) { tr_item(p.w_ukv + (size_t)l * 512 * 2048, 512, 2048, 2048, wl + LW_UKV, 0, scr, r, lane); continue; } r -= I_UKV;
        if (r < I_O)  { tr_item(p.w_oa + (size_t)l * 1024 * 2048, 1024, 2048, 2048, wl + LW_OA, 0, scr, r, lane, 2048); continue; } r -= I_O;
        if (r < I_O)  { tr_item(p.w_ob + (size_t)l * 1024 * 2048, 1024, 2048, 2048, wl + LW_OA + 1024, 0, scr, r, lane, 2048); continue; } r -= I_O;
        tr_item(p.w_out + (size_t)l * 2048 * 2048, 2048, 2048, 2048, wl + LW_OUT, 0, scr, r, lane);
    }
}

template <bool DELTA, bool FINAL, bool XI16 = false, bool XO16 = false>
__device__ __forceinline__ void thin_phase(const void* xin_, void* xout_, const bf16* delta, const float* gate, float coef, const float* g, const float* sh, const float* sc, bf16* H, int vcu, int G, const int wave_s) {
    LOCAL_IDS();
    unsigned lo16 = (unsigned)lane * 16u, lo8 = (unsigned)lane * 8u;
#define LD16(base, j) (*(const f32x4*)((const char*)(base) + lo16 + (unsigned)(j) * 1024u))
#define ST16(base, j, v) (*(f32x4*)((char*)(base) + lo16 + (unsigned)(j) * 1024u) = (v))
#define LD8(base, j) (*(const v2u*)((const char*)(base) + lo8 + (unsigned)(j) * 512u))
#define ST8(base, j, v) (*(v2u*)((char*)(base) + lo8 + (unsigned)(j) * 512u) = (v))
    for (int blk = gw; blk < M / 16; blk += NGW) {
        const int row0 = blk * 16, b = row0 >> 12;
        const float* scb = sc + (size_t)b * NMOD; const float* shb = sh + (size_t)b * NMOD; const float* gtb = gate + (size_t)b * NMOD;
        f32x4 ca[8], cs[8], cg[8];
#pragma unroll
        for (int j = 0; j < 8; ++j) { const f32x4 gv = LD16(g, j);
            if (FINAL) { ca[j] = gv; cs[j] = (f32x4){0.f, 0.f, 0.f, 0.f}; }
            else { ca[j] = gv * (LD16(scb, j) + 1.0f); cs[j] = LD16(shb, j); }
            if (DELTA) cg[j] = LD16(gtb, j) * coef; }
        for (int i = 0; i < 16; i += 2) {
            asm volatile("" : "+v"(lo16), "+v"(lo8));
            const size_t r0 = (size_t)(row0 + i) * D;
            f32x4 v0[8], v1[8]; float ss0 = 0.f, ss1 = 0.f;
            if (XI16) { const _Float16* x0 = (const _Float16*)xin_ + r0; const _Float16* x1 = x0 + D; v2u a0[8], a1[8];
#pragma unroll
                for (int j = 0; j < 8; ++j) { a0[j] = LD8(x0, j); a1[j] = LD8(x1, j); }
#pragma unroll
                for (int j = 0; j < 8; ++j) { v0[j] = __builtin_convertvector(__builtin_bit_cast(h16x4, a0[j]), f32x4); v1[j] = __builtin_convertvector(__builtin_bit_cast(h16x4, a1[j]), f32x4); } }
            else { const float* x0 = (const float*)xin_ + r0; const float* x1 = x0 + D;
#pragma unroll
                for (int j = 0; j < 8; ++j) { v0[j] = LD16(x0, j); v1[j] = LD16(x1, j); } }
            if (DELTA) { const bf16* dl0 = delta + r0; const bf16* dl1 = dl0 + D; v2u d0[8], d1[8];
#pragma unroll
                for (int j = 0; j < 8; ++j) { d0[j] = LD8(dl0, j); d1[j] = LD8(dl1, j); }
#pragma unroll
                for (int j = 0; j < 8; ++j) {
                    v0[j] = v0[j] + cg[j] * (f32x4){__uint_as_float(d0[j].x << 16), __uint_as_float(d0[j].x & 0xffff0000u), __uint_as_float(d0[j].y << 16), __uint_as_float(d0[j].y & 0xffff0000u)};
                    v1[j] = v1[j] + cg[j] * (f32x4){__uint_as_float(d1[j].x << 16), __uint_as_float(d1[j].x & 0xffff0000u), __uint_as_float(d1[j].y << 16), __uint_as_float(d1[j].y & 0xffff0000u)}; }
                if (!FINAL && XO16) { _Float16* xo0 = (_Float16*)xout_ + r0; _Float16* xo1 = xo0 + D;
#pragma unroll
                    for (int j = 0; j < 8; ++j) { ST8(xo0, j, __builtin_bit_cast(v2u, __builtin_convertvector(v0[j], h16x4))); ST8(xo1, j, __builtin_bit_cast(v2u, __builtin_convertvector(v1[j], h16x4))); } }
                if (!FINAL && !XO16) { float* xo0 = (float*)xout_ + r0; float* xo1 = xo0 + D;
#pragma unroll
                    for (int j = 0; j < 8; ++j) { ST16(xo0, j, v0[j]); ST16(xo1, j, v1[j]); } } }
#pragma unroll
            for (int j = 0; j < 8; ++j) { ss0 += (v0[j].x * v0[j].x + v0[j].y * v0[j].y) + (v0[j].z * v0[j].z + v0[j].w * v0[j].w); ss1 += (v1[j].x * v1[j].x + v1[j].y * v1[j].y) + (v1[j].z * v1[j].z + v1[j].w * v1[j].w); }
            const float rstd0 = 1.0f / sqrtf(wave_sum(ss0) * (1.0f / D) + EPS), rstd1 = 1.0f / sqrtf(wave_sum(ss1) * (1.0f / D) + EPS);
            if (FINAL) { float* xo0 = (float*)xout_ + r0; float* xo1 = xo0 + D;
#pragma unroll
                for (int j = 0; j < 8; ++j) { ST16(xo0, j, v0[j] * rstd0 * ca[j]); ST16(xo1, j, v1[j] * rstd1 * ca[j]); } }
            else { bf16* h0p = H + r0; bf16* h1p = h0p + D;
#pragma unroll
                for (int j = 0; j < 8; ++j) { const f32x4 h0 = v0[j] * rstd0 * ca[j] + cs[j], h1 = v1[j] * rstd1 * ca[j] + cs[j]; v2u w0, w1; w0.x = pk2(h0.x, h0.y); w0.y = pk2(h0.z, h0.w); w1.x = pk2(h1.x, h1.y); w1.y = pk2(h1.z, h1.w); ST8(h0p, j, w0); ST8(h1p, j, w1); } }
        }
    }
#undef LD16
#undef ST16
#undef LD8
#undef ST8
}
#ifndef EN_PRO
#define EN_PRO 1
#endif
#ifndef EN_ATT
#define EN_ATT 1
#endif
#ifndef EN_G1
#define EN_G1 1
#endif
#ifndef EN_G2
#define EN_G2 1
#endif
#ifndef EN_G4
#define EN_G4 1
#endif
#ifndef EN_G6
#define EN_G6 1
#endif
#ifndef EN_G8
#define EN_G8 1
#endif
#ifndef EN_G9
#define EN_G9 1
#endif
#ifndef EN_G11
#define EN_G11 1
#endif
#ifndef EN_G12
#define EN_G12 1
#endif
struct Args { const void* in[21]; float* out; unsigned char* ws; int ph_lo, ph_hi; };
#ifndef ALIGN_WIN
#define ALIGN_WIN true
#endif
#ifndef GEMM_ALIGN
#define GEMM_ALIGN true
#endif
#ifndef GEMM_SP2
#define GEMM_SP2 true
#endif
#ifndef WGM_S
#define WGM_S 8
#endif
#ifndef REV_D
#define REV_D 0
#endif
#ifndef WGM_GU
#define WGM_GU 8
#endif
#ifndef WGM_WIN
#define WGM_WIN 8
#endif
#ifndef WGM_D
#define WGM_D 4
#endif
#ifndef FCH
#define FCH 1
#endif
constexpr int MC = M / FCH;
enum { P_N1 = 0, P_F1 = 1, P_N2 = P_F1 + FCH + 1, P_WIN, P_UQ, P_ATT, P_OAB, P_WOUT, P_N3, P_F2, PH_PER_LAYER = P_F2 + FCH + 1 };
constexpr int N_PHASES = 2 + DEPTH * PH_PER_LAYER;

__global__ void __launch_bounds__(NWAVES * 64, 2) mega_fwd(Args args) {
    extern __shared__ __attribute__((aligned(16))) unsigned char lds_raw[];
    LAS unsigned char* lds = (LAS unsigned char*)lds_raw;
    const int tid = threadIdx.x; const int wave_s = __builtin_amdgcn_readfirstlane(tid >> 6);
    const int G = gridDim.x, bx = blockIdx.x, vcu = (G % 8 == 0) ? (bx % 8) * (G / 8) + bx / 8 : bx;
    P p;
    p.x = (const float*)args.in[0]; p.c = (const float*)args.in[1]; p.pos = (const int*)args.in[2]; p.norm_g = (const float*)args.in[3]; p.w_ada = (const float*)args.in[4]; p.b_ada = (const float*)args.in[5];
    p.w_gu1 = (const float*)args.in[6]; p.w_d1 = (const float*)args.in[7]; p.w_gu2 = (const float*)args.in[8]; p.w_d2 = (const float*)args.in[9]; p.w_in = (const float*)args.in[10]; p.b_gate = (const float*)args.in[11];
    p.sink = (const float*)args.in[12]; p.g_cq = (const float*)args.in[13]; p.g_ckv = (const float*)args.in[14]; p.w_uq = (const float*)args.in[15]; p.w_ukv = (const float*)args.in[16];
    p.w_oa = (const float*)args.in[17]; p.w_ob = (const float*)args.in[18]; p.w_out = (const float*)args.in[19]; p.g_final = (const float*)args.in[20];
    p.out = args.out; p.ws = args.ws;
    unsigned char* ws = args.ws;
    for (int u = tid; u < (LDS_BYTES - LDSCTL_OFF) / 4; u += NWAVES * 64) ((LAS unsigned*)(lds + LDSCTL_OFF))[u] = 0u;
    __syncthreads();
    const int lo = args.ph_lo, hi = args.ph_hi;
    XcdBarrier bar; bar.bar = (unsigned*)(ws + WS_CTL) + CW_BAR; bar.x = 0; bar.st = nullptr;
    if (hi - lo > 1) bar = xcd_barrier_post((unsigned*)(ws + WS_CTL) + CW_BAR, (volatile LAS unsigned*)(lds + LDSCTL_OFF) + 8);
#define IN(k) (lo <= (k) && (k) < hi)
#define SEAM(k) do { if (IN(k) && IN((k) + 1)) xcd_barrier(bar); } while (0)

#define WSL() ({ unsigned long long w_ = (unsigned long long)ws; asm volatile("" : "+s"(w_)); (unsigned char*)(GAS unsigned char*)w_; })
#define mod   ((float*)(WSL() + WS_MOD))
#define cosA  ((const float*)(WSL() + WS_COSA))
#define sinA  ((const float*)(WSL() + WS_SINA))
#define cosR  ((const float*)(WSL() + WS_COSR))
#define sinR  ((const float*)(WSL() + WS_SINR))
#define H     ((bf16*)p.out)
#define X16   ((_Float16*)(WSL() + WS_X16))
#define big   (WSL() + WS_BIG)
#define ACT   ((bf16*)(big + B_ACT))
#define QA    ((bf16*)(big + B_QA))
#define KA    ((bf16*)(big + B_KA))
#define VA    ((bf16*)(big + B_VA))
#define CQN   ((bf16*)(big + B_CQN))
#define CKVN  ((bf16*)(big + B_CKVN))
#define KR    ((bf16*)(big + B_KR))
#define GATES ((unsigned char*)(big + B_GATES))
#define QBN   ((bf16*)(big + B_QA) + 1024)
#define QBR   ((bf16*)(big + B_QBR))
#define KVB   ((bf16*)(big + B_KVB))
#define MIX   H
#define DELTA ((bf16*)(big + B_DELTA))
#define SSQ   ((float*)(WSL() + WS_SS) + (size_t)(2 * l) * M)
#define SSKV  ((float*)(WSL() + WS_SS) + (size_t)(2 * l + 1) * M)

    if (EN_PRO && IN(0)) { prologue(p, lds, vcu, G, false, wave_s); VM_WAIT(); __syncthreads();
    }
    SEAM(0);

#pragma unroll 1
    for (int l = 0; l < DEPTH; ++l) {
        const int pb = 1 + l * PH_PER_LAYER;
#define wl ((const bf16*)(WSL() + WS_W) + (size_t)l * LW_ELEMS)
#define ml (mod + (size_t)l * 8 * NMOD)
        const float* ng = p.norm_g + (size_t)l * 3 * D;
        if (IN(pb + P_N1)) { if (l == 0) thin_phase<false, false>(p.x, X16, DELTA, ml, 0.f, ng, ml + 0 * D, ml + 1 * D, H, vcu, G, wave_s);
                             else thin_phase<true, false, true, true>(X16, X16, DELTA, mod + 8 * D, 0.5f, ng, ml + 0 * D, ml + 1 * D, H, vcu, G, wave_s); }
        SEAM(pb + P_N1);
#pragma unroll 1
        for (int s_ = 0; s_ <= FCH; ++s_) {
            if (IN(pb + P_F1 + s_)) {
                if (s_ > 0) { const int c_ = s_ - 1; pg8::Gemm g{ACT + (size_t)c_ * MC * FF, wl + LW_D1, MC, D, FF}; pg8::StaticOrder S; S.init(MC, D, G, bx, WGM_D); S.rev = REV_D;
                    pg8::EpiPlainBf16 E{DELTA + (size_t)c_ * MC * D, D};
                    pg8::gemm_phase<pg8::EpiPlainBf16, pg8::StaticOrder, GEMM_ALIGN, GEMM_SP2>(lds, g, S, E, wave_s); }
                if (s_ < FCH) { const int c_ = s_; pg8::Gemm g{H + (size_t)c_ * MC * D, wl + LW_GU1, MC, 2 * FF, D}; pg8::StaticOrder S; S.init(MC, 2 * FF, G, bx, WGM_GU); pg8::EpiSwiglu E{ACT + (size_t)c_ * MC * FF, FF};
                    pg8::gemm_phase<pg8::EpiSwiglu, pg8::StaticOrder, GEMM_ALIGN, GEMM_SP2>(lds, g, S, E, wave_s); }
            }
            SEAM(pb + P_F1 + s_);
        }
        if (IN(pb + P_N2)) { if (l == 0) thin_phase<true, false, false, true>(p.x, X16, DELTA, ml + 2 * D, 0.5f, ng + D, ml + 3 * D, ml + 4 * D, H, vcu, G, wave_s);
                             else thin_phase<true, false, true, true>(X16, X16, DELTA, ml + 2 * D, 0.5f, ng + D, ml + 3 * D, ml + 4 * D, H, vcu, G, wave_s); }
        SEAM(pb + P_N2);
        if (IN(pb + P_WIN)) { pg8::Gemm g{H, wl + LW_IN, M, WIN_N, D}; pg8::StaticOrder S; S.init(M, WIN_N, G, bx, WGM_WIN);
            pg8::EpiWin E{QA, KA, VA, KR, GATES, CQN, CKVN, SSQ, SSKV, p.g_cq + l * 512, p.g_ckv + l * 512, cosA, sinA, cosR, sinR, p.b_gate + (size_t)l * 2 * D};
            pg8::gemm_phase<pg8::EpiWin, pg8::StaticOrder, ALIGN_WIN, GEMM_SP2>(lds, g, S, E, wave_s); }
        SEAM(pb + P_WIN);
        if (IN(pb + P_UQ)) {
            { pg8::Gemm g{CQN, wl + LW_UQ, M, 1536, 512}; pg8::StaticOrder S; S.init(M, 1536, G, bx); pg8::EpiUq E{QBN, QBR, cosR, sinR, SSQ};
              pg8::gemm_phase<pg8::EpiUq, pg8::StaticOrder, GEMM_ALIGN, GEMM_SP2>(lds, g, S, E, wave_s); }
            { pg8::Gemm g{CKVN, wl + LW_UKV, M, 2048, 512}; pg8::StaticOrder S; S.init(M, 2048, G, bx, WGM_S); pg8::EpiScaledBf16 E{KVB, 2048, SSKV};
              pg8::gemm_phase<pg8::EpiScaledBf16, pg8::StaticOrder, GEMM_ALIGN, GEMM_SP2>(lds, g, S, E, wave_s); }
        }
        SEAM(pb + P_UQ);
        if (IN(pb + P_ATT)) {
            for (int u = vcu; u < NB * 8 * 16; u += G) { const int bh = u >> 4, qb = u & 15, b = bh >> 3, h = bh & 7; const size_t r0 = (size_t)b * SEQ + qb * 256, k0 = (size_t)b * SEQ;
                att::attn_body_dma<true, 2048, 512, 2048>(QBN + r0 * 2048 + h * 128, QBR + r0 * 512 + h * 64, KVB + k0 * 2048 + h * 256, KVB + k0 * 2048 + h * 256 + 128, KR + k0 * 64,
                                                      QBN + r0 * 2048 + h * 128, SEQ / 64, 0.07216878364870322f * 1.4426950408889634f, 8.0f / 0.07216878364870322f, -1e30f, 0.f, 0, 0, (char*)lds_raw, wave_s); }
            for (int u = vcu; u < NB * 8 * 16; u += G) { const int bh = u >> 4, qb = u & 15, b = bh >> 3, h = bh & 7, i0 = qb * 256; const size_t r0 = (size_t)b * SEQ + i0;
                const int klo = i0 >= 128 ? i0 - 128 : 0, khi = i0 + 384 <= SEQ ? i0 + 384 : SEQ; const size_t k0 = (size_t)b * SEQ + klo;
                const float sk = p.sink[l * 8 + h];
                att::attn_body_dma<false, 2048, 512, 256>(QA + r0 * 2048 + h * 128, nullptr, KA + k0 * 256 + (h >> 2) * 128, VA + k0 * 256 + (h >> 2) * 128, nullptr,
                                                      QA + r0 * 2048 + h * 128, (khi - klo) / 64, 0.08838834764831845f * 1.4426950408889634f, 8.0f / 0.08838834764831845f, sk / 0.08838834764831845f, 1.f, i0, klo, (char*)lds_raw, wave_s); }
        }
        SEAM(pb + P_ATT);
        if (IN(pb + P_OAB)) { pg8::Gemm g{QA, wl + LW_OA, M, D, 2048}; pg8::StaticOrder S; S.init(M, D, G, bx, WGM_S); pg8::EpiGateMerge E{GATES, MIX};
            pg8::gemm_phase<pg8::EpiGateMerge, pg8::StaticOrder, GEMM_ALIGN, GEMM_SP2>(lds, g, S, E, wave_s); }
        SEAM(pb + P_OAB);
        if (IN(pb + P_WOUT)) { pg8::Gemm g{MIX, wl + LW_OUT, M, D, D}; pg8::StaticOrder S; S.init(M, D, G, bx, WGM_S); pg8::EpiPlainBf16 E{DELTA, D};
            pg8::gemm_phase<pg8::EpiPlainBf16, pg8::StaticOrder, GEMM_ALIGN, GEMM_SP2>(lds, g, S, E, wave_s); }
        SEAM(pb + P_WOUT);
        if (IN(pb + P_N3)) thin_phase<true, false, true, true>(X16, X16, DELTA, ml + 5 * D, 1.0f, ng + 2 * D, ml + 6 * D, ml + 7 * D, H, vcu, G, wave_s);
        SEAM(pb + P_N3);
#pragma unroll 1
        for (int s_ = 0; s_ <= FCH; ++s_) {
            if (IN(pb + P_F2 + s_)) {
                if (s_ > 0) { const int c_ = s_ - 1; pg8::Gemm g{ACT + (size_t)c_ * MC * FF, wl + LW_D2, MC, D, FF}; pg8::StaticOrder S; S.init(MC, D, G, bx, WGM_D); S.rev = REV_D;
                    pg8::EpiPlainBf16 E{DELTA + (size_t)c_ * MC * D, D};
                    pg8::gemm_phase<pg8::EpiPlainBf16, pg8::StaticOrder, GEMM_ALIGN, GEMM_SP2>(lds, g, S, E, wave_s); }
                if (s_ < FCH) { const int c_ = s_; pg8::Gemm g{H + (size_t)c_ * MC * D, wl + LW_GU2, MC, 2 * FF, D}; pg8::StaticOrder S; S.init(MC, 2 * FF, G, bx, WGM_GU); pg8::EpiSwiglu E{ACT + (size_t)c_ * MC * FF, FF};
                    pg8::gemm_phase<pg8::EpiSwiglu, pg8::StaticOrder, GEMM_ALIGN, GEMM_SP2>(lds, g, S, E, wave_s); }
            }
            SEAM(pb + P_F2 + s_);
        }
    }
    if (IN(N_PHASES - 1)) thin_phase<true, true, true, false>(X16, p.out, DELTA, mod + (size_t)8 * NMOD + 8 * D, 0.5f, p.g_final, p.g_final, p.g_final, H, vcu, G, wave_s);
#undef IN
#undef SEAM
}

extern "C" void kernel_launch(void* const* d_in, const int* in_sizes, int n_in, void* d_out, int out_size, void* d_ws, size_t ws_size, hipStream_t stream) {
    static int grid = 0;
    if (grid == 0) {
        if (n_in != 21 || in_sizes[0] != M * D || out_size != M * D || ws_size < WS_END) {
            fprintf(stderr, "kernel_launch: built for 21 inputs, x/out of %d floats, >= %zu bytes of workspace; got n_in %d, in0 %d, out %d, ws %zu; nothing launched\n", M * D, (size_t)WS_END, n_in, n_in > 0 ? in_sizes[0] : -1, out_size, ws_size);
            grid = -1; return; }
        int dev = 0, cus = 0, per_cu = 0;
        if (hipGetDevice(&dev) != hipSuccess || hipDeviceGetAttribute(&cus, hipDeviceAttributeMultiprocessorCount, dev) != hipSuccess) { fprintf(stderr, "kernel_launch: device query failed\n"); grid = -1; return; }
        if (hipFuncSetAttribute((const void*)mega_fwd, hipFuncAttributeMaxDynamicSharedMemorySize, LDS_BYTES) != hipSuccess) { fprintf(stderr, "kernel_launch: hipFuncSetAttribute failed\n"); grid = -1; return; }
        if (hipOccupancyMaxActiveBlocksPerMultiprocessor(&per_cu, (const void*)mega_fwd, NWAVES * 64, LDS_BYTES) != hipSuccess || per_cu < 1)
            fprintf(stderr, "kernel_launch: note: occupancy query reports %d workgroups per CU\n", per_cu);
        (void)hipGetLastError();
        grid = cus;
    }
    if (grid < 0) return;
    if (hipMemsetAsync((char*)d_ws + WS_CTL, 0, WS_ZERO_BYTES, stream) != hipSuccess) { fprintf(stderr, "kernel_launch: memset failed\n"); return; }
    Args a{};
    for (int i = 0; i < 21; ++i) a.in[i] = d_in[i];
    a.out = (float*)d_out; a.ws = (unsigned char*)d_ws;
#if MK_ONE_LAUNCH
    a.ph_lo = 0; a.ph_hi = N_PHASES;
    hipLaunchKernelGGL(mega_fwd, dim3(grid), dim3(NWAVES * 64), LDS_BYTES, stream, a);
#else
    for (int ph = 0; ph < N_PHASES; ++ph) { a.ph_lo = ph; a.ph_hi = ph + 1;
        hipLaunchKernelGGL(mega_fwd, dim3(grid), dim3(NWAVES * 64), LDS_BYTES, stream, a);
    }
#endif
    const hipError_t le = hipPeekAtLastError();
    if (le != hipSuccess) fprintf(stderr, "kernel_launch: launch failed: %s\n", hipGetErrorName(le));
}
```

```cpp
#include <hip/hip_runtime.h>
#include <cstdio>
#include <cstdint>
#include <cmath>

#ifndef MERGE_MID
#define MERGE_MID true
#endif
#ifndef MK_ONE_LAUNCH
#define MK_ONE_LAUNCH 1
#endif

__device__ __forceinline__ int lane_id_fresh() { int l; asm volatile("v_mbcnt_lo_u32_b32 %0, -1, 0\n\tv_mbcnt_hi_u32_b32 %0, -1, %0" : "=v"(l)); return l; }

namespace pg8 {
#define PG8_LAS __attribute__((address_space(3)))
typedef unsigned short bf16_t;
typedef short bf16x8 __attribute__((ext_vector_type(8)));
typedef float f32x4 __attribute__((ext_vector_type(4)));
typedef unsigned u32x4 __attribute__((ext_vector_type(4)));
constexpr int BM = 256, BK = 64, HALF = 128, HTB = HALF * BK * 2  , STAGE_BYTES = 8 * HTB, NXCD = 8, WGM = 8;

__host__ __device__ __forceinline__ int lds_byte(int r, int c) { const int st = (r >> 4) * 2 + (c >> 5), rr = r & 15, cc = c & 31, ob = rr * 64 + cc * 2; return st * 1024 + (ob ^ (((ob >> 9) & 1) << 5)); }
__host__ __device__ __forceinline__ void stage_rc(int b, int& R, int& C) { const int st = b / 1024, sb = b % 1024, swz = sb ^ (((sb >> 9) & 1) << 5); R = (st >> 1) * 16 + swz / 64; C = (st & 1) * 32 + (swz % 64) / 2; }
__host__ __device__ __forceinline__ int perm32(int rho) { const int n = rho >> 4, i = rho & 15; return 8 * (i >> 2) + 4 * n + (i & 3); }

struct Unit { int pm, pn; };
struct Gemm { const bf16_t* A; const bf16_t* Bt; int M, N, K; };

struct StaticOrder {
    int nM, nN, nwg, G, c, wgm, rev;
    int pad_;
    __host__ __device__ void init(int M, int N, int G_, int c_, int wgm_ = WGM) { nM = M / BM; nN = N / BM; nwg = nM * nN; G = G_; c = c_; wgm = wgm_; rev = 0; pad_ = 0; }
    __host__ __device__ bool next(int i, Unit& u) const {
        const long L = (long)i * G + c; if (L >= nwg) return false;
        int wgid = (int)L; { const int q = nwg / NXCD, r = nwg % NXCD, xcd = wgid % NXCD, off = wgid / NXCD; wgid = (xcd < r ? xcd * (q + 1) : r * (q + 1) + (xcd - r) * q) + off; }
        const int nig = wgm * nN, gid = wgid / nig, fm = gid * wgm, gsz = (nM - fm) < wgm ? (nM - fm) : wgm;
        u.pm = fm + ((wgid % nig) % gsz); u.pn = (wgid % nig) / gsz; if (rev) u.pm = nM - 1 - u.pm; return true;
    }
    __device__ __forceinline__ void a_ready(const Unit&) const {}
    __device__ __forceinline__ void done(const Unit&) const {}
};
typedef __bf16 bf16x2_t __attribute__((ext_vector_type(2)));
__device__ __forceinline__ unsigned cvt_pk_bf16(float lo, float hi) { const float __attribute__((ext_vector_type(2))) v = {lo, hi}; return __builtin_bit_cast(unsigned, __builtin_convertvector(v, bf16x2_t)); }
typedef float f32x2 __attribute__((ext_vector_type(2)));
typedef unsigned u32x2 __attribute__((ext_vector_type(2)));
__device__ __forceinline__ float bf_lo(unsigned w) { return __uint_as_float(w << 16); }
__device__ __forceinline__ float bf_hi(unsigned w) { return __uint_as_float(w & 0xffff0000u); }
__device__ __forceinline__ float fast_sigmoid(float x) { return __builtin_amdgcn_rcpf(1.0f + __builtin_amdgcn_exp2f(-1.4426950408889634f * x)); }
__device__ __forceinline__ f32x2 fast_sigmoid2(f32x2 x) {
    const f32x2 t = x * (f32x2){-1.4426950408889634f, -1.4426950408889634f}; f32x2 e = {__builtin_amdgcn_exp2f(t.x), __builtin_amdgcn_exp2f(t.y)};
    e += (f32x2){1.0f, 1.0f}; return (f32x2){__builtin_amdgcn_rcpf(e.x), __builtin_amdgcn_rcpf(e.y)}; }
__device__ __forceinline__ u32x4 pack8(const f32x4 a, const f32x4 b) { u32x4 w; w.x = cvt_pk_bf16(a[0], a[1]); w.y = cvt_pk_bf16(a[2], a[3]); w.z = cvt_pk_bf16(b[0], b[1]); w.w = cvt_pk_bf16(b[2], b[3]); return w; }

struct EpiSwiglu {
    static constexpr bool PERM = true, AFTER_DRAIN = false, MID = false;
    bf16_t* O; int ldc;
    __device__ __forceinline__ void operator()(const f32x4 (&acc)[2][2][4][2], const Unit& u, int wr, int wc, int fr, int fq) const {
        const int row0 = u.pm * BM + wr * 64 + fr, col0 = u.pn * HALF + wc * 32 + 8 * fq;
#pragma unroll
        for (int ai = 0; ai < 2; ++ai)
#pragma unroll
            for (int m = 0; m < 4; ++m) { bf16_t* rowp = O + (size_t)(row0 + ai * HALF + m * 16) * ldc + col0;
                f32x4 v[2];
#pragma unroll
                for (int n = 0; n < 2; ++n) { const f32x4 g = acc[ai][0][m][n], up = acc[ai][1][m][n];
#pragma unroll
                    for (int i = 0; i < 4; i += 2) { const f32x2 g2 = {g[i], g[i + 1]}, o2 = g2 * fast_sigmoid2(g2) * (f32x2){up[i], up[i + 1]}; v[n][i] = o2.x; v[n][i + 1] = o2.y; } }
                *(u32x4*)rowp = pack8(v[0], v[1]); }
    }
};

struct EpiPlainBf16 {
    static constexpr bool PERM = true, AFTER_DRAIN = false, MID = false;
    bf16_t* O; int ldc;
    __device__ __forceinline__ void operator()(const f32x4 (&acc)[2][2][4][2], const Unit& u, int wr, int wc, int fr, int fq) const {
        const int row0 = u.pm * BM + wr * 64 + fr, col0 = u.pn * BM + wc * 32 + 8 * fq;
#pragma unroll
        for (int ai = 0; ai < 2; ++ai)
#pragma unroll
            for (int m = 0; m < 4; ++m) { bf16_t* rowp = O + (size_t)(row0 + ai * HALF + m * 16) * ldc + col0;
#pragma unroll
                for (int bj = 0; bj < 2; ++bj) *(u32x4*)(rowp + bj * HALF) = pack8(acc[ai][bj][m][0], acc[ai][bj][m][1]); }
    }
};

struct EpiResid16 {
    static constexpr bool PERM = true, AFTER_DRAIN = false, MID = false;
    typedef _Float16 h16x4_t __attribute__((ext_vector_type(4)));
    _Float16* X; const float* gate; int gpitch; float coef;
    __device__ __forceinline__ void operator()(const f32x4 (&acc)[2][2][4][2], const Unit& u, int wr, int wc, int fr, int fq) const {
        const int row0 = u.pm * BM + wr * 64 + fr, col0 = u.pn * BM + wc * 32 + 8 * fq;
        const float* gp = gate + (size_t)((u.pm * BM) >> 12) * gpitch + col0;
        f32x4 cg[2][2];
#pragma unroll
        for (int bj = 0; bj < 2; ++bj)
#pragma unroll
            for (int n = 0; n < 2; ++n) cg[bj][n] = *(const f32x4*)(gp + bj * HALF + 4 * n) * coef;
#pragma unroll
        for (int ai = 0; ai < 2; ++ai) {
            u32x4 xv[4][2];
#pragma unroll
            for (int m = 0; m < 4; ++m)
#pragma unroll
                for (int bj = 0; bj < 2; ++bj) xv[m][bj] = *(const u32x4*)(X + (size_t)(row0 + ai * HALF + m * 16) * 2048 + col0 + bj * HALF);
#pragma unroll
            for (int m = 0; m < 4; ++m)
#pragma unroll
                for (int bj = 0; bj < 2; ++bj) { const u32x4 w = xv[m][bj];
                    const f32x4 x0 = __builtin_convertvector(__builtin_bit_cast(h16x4_t, (u32x2){w.x, w.y}), f32x4), x1 = __builtin_convertvector(__builtin_bit_cast(h16x4_t, (u32x2){w.z, w.w}), f32x4);
                    const f32x4 o0 = x0 + cg[bj][0] * acc[ai][bj][m][0], o1 = x1 + cg[bj][1] * acc[ai][bj][m][1];
                    const u32x2 p0 = __builtin_bit_cast(u32x2, __builtin_convertvector(o0, h16x4_t)), p1 = __builtin_bit_cast(u32x2, __builtin_convertvector(o1, h16x4_t));
                    *(u32x4*)(X + (size_t)(row0 + ai * HALF + m * 16) * 2048 + col0 + bj * HALF) = (u32x4){p0.x, p0.y, p1.x, p1.y}; }
        }
    }
};

template <int NF> __device__ __forceinline__ void rope_store(const f32x4 (&acc)[2][2][4][2], int ai, int m, const float* cosT, const float* sinT, size_t row, int d0, bf16_t* o1p, bf16_t* o2p) {
    const f32x4 c0 = *(const f32x4*)(cosT + row * NF + d0), c1 = *(const f32x4*)(cosT + row * NF + d0 + 4);
    const f32x4 s0 = *(const f32x4*)(sinT + row * NF + d0), s1 = *(const f32x4*)(sinT + row * NF + d0 + 4);
    const f32x4 a0 = acc[ai][0][m][0], a1 = acc[ai][0][m][1], b0 = acc[ai][1][m][0], b1 = acc[ai][1][m][1];
    const f32x4 r0 = a0 * c0 - b0 * s0, r1 = a1 * c1 - b1 * s1, q0 = b0 * c0 + a0 * s0, q1 = b1 * c1 + a1 * s1;
    *(u32x4*)o1p = pack8(r0, r1); *(u32x4*)o2p = pack8(q0, q1);
}

struct EpiWin {
    static constexpr bool PERM = true, AFTER_DRAIN = false, MID = false;
    bf16_t *QA, *KA, *VA, *KR; unsigned char* GATES; bf16_t *CQN, *CKVN; float *SSQ, *SSKV; const float *gq, *gkv, *cosA, *sinA, *cosR, *sinR, *bgate;
    __device__ __forceinline__ void operator()(const f32x4 (&acc)[2][2][4][2], const Unit& u, int wr, int wc, int fr, int fq) const {
        const int row0 = u.pm * BM + wr * 64 + fr, pn = u.pn;
        if (pn <= 4) {
            const int hsel = wc >> 1, d0 = 32 * (wc & 1) + 8 * fq;
            bf16_t* base; int ld, head;
            if (pn < 4) { base = QA; ld = 2048; head = 2 * pn + hsel; } else { base = KA; ld = 256; head = hsel; }
#pragma unroll
            for (int ai = 0; ai < 2; ++ai)
#pragma unroll
                for (int m = 0; m < 4; ++m) { const size_t row = (size_t)(row0 + ai * HALF + m * 16); bf16_t* o1 = base + row * ld + head * 128 + d0;
                    rope_store<64>(acc, ai, m, cosA, sinA, row, d0, o1, o1 + 64); }
        } else if (pn == 5) {
            const int col0 = wc * 32 + 8 * fq;
#pragma unroll
            for (int ai = 0; ai < 2; ++ai)
#pragma unroll
                for (int m = 0; m < 4; ++m) { bf16_t* rowp = VA + (size_t)(row0 + ai * HALF + m * 16) * 256 + col0;
#pragma unroll
                    for (int bj = 0; bj < 2; ++bj) *(u32x4*)(rowp + bj * HALF) = pack8(acc[ai][bj][m][0], acc[ai][bj][m][1]); }
        } else if (pn <= 9) {
            bf16_t* base = pn <= 7 ? CQN : CKVN; float* ssp = pn <= 7 ? SSQ : SSKV; const float* gp = (pn <= 7 ? gq : gkv); const int col0 = ((pn - 6) & 1) * 256 + wc * 32 + 8 * fq;
            f32x4 gv[2][2];
#pragma unroll
            for (int bj = 0; bj < 2; ++bj)
#pragma unroll
                for (int n = 0; n < 2; ++n) gv[bj][n] = *(const f32x4*)(gp + col0 + bj * HALF + 4 * n);
#pragma unroll
            for (int ai = 0; ai < 2; ++ai)
#pragma unroll
                for (int m = 0; m < 4; ++m) { const size_t row = (size_t)(row0 + ai * HALF + m * 16); bf16_t* rowp = base + row * 512 + col0; float ssq = 0.f;
#pragma unroll
                    for (int bj = 0; bj < 2; ++bj) {
#pragma unroll
                        for (int n = 0; n < 2; ++n) { const f32x4 t = acc[ai][bj][m][n]; ssq += (t[0] * t[0] + t[1] * t[1]) + (t[2] * t[2] + t[3] * t[3]); }
                        *(u32x4*)(rowp + bj * HALF) = pack8(acc[ai][bj][m][0] * gv[bj][0], acc[ai][bj][m][1] * gv[bj][1]); }
                    { auto r = __builtin_amdgcn_permlane16_swap(__float_as_uint(ssq), __float_as_uint(ssq), false, false); ssq = __uint_as_float(r[0]) + __uint_as_float(r[1]); }
                    { auto r = __builtin_amdgcn_permlane32_swap(__float_as_uint(ssq), __float_as_uint(ssq), false, false); ssq = __uint_as_float(r[0]) + __uint_as_float(r[1]); }
                    if (fq == 0) unsafeAtomicAdd(ssp + row, ssq); }
        } else if (pn == 10) {
            if (wc == 0) { const int d0 = 8 * fq;
#pragma unroll
                for (int ai = 0; ai < 2; ++ai)
#pragma unroll
                    for (int m = 0; m < 4; ++m) { const size_t row = (size_t)(row0 + ai * HALF + m * 16); bf16_t* o1 = KR + row * 64 + d0;
                        rope_store<32>(acc, ai, m, cosR, sinR, row, d0, o1, o1 + 32); } }
        } else {
            const int col0 = (pn - 11) * 256 + wc * 32 + 8 * fq;
            f32x4 bv[2][2];
#pragma unroll
            for (int bj = 0; bj < 2; ++bj)
#pragma unroll
                for (int n = 0; n < 2; ++n) bv[bj][n] = *(const f32x4*)(bgate + col0 + bj * HALF + 4 * n);
#pragma unroll
            for (int ai = 0; ai < 2; ++ai)
#pragma unroll
                for (int m = 0; m < 4; ++m) { unsigned char* rowp = GATES + (size_t)(row0 + ai * HALF + m * 16) * 4096 + col0;
#pragma unroll
                    for (int bj = 0; bj < 2; ++bj) { u32x2 w;
#pragma unroll
                        for (int n = 0; n < 2; ++n) { const f32x4 t = acc[ai][bj][m][n] + bv[bj][n]; unsigned q[4];
#pragma unroll
                            for (int i = 0; i < 4; i += 2) { const f32x2 s2 = __builtin_elementwise_fma(fast_sigmoid2((f32x2){t[i], t[i + 1]}), (f32x2){255.0f, 255.0f}, (f32x2){8388608.0f, 8388608.0f});
                                q[i] = __float_as_uint(s2.x); q[i + 1] = __float_as_uint(s2.y); }
                            w[n] = __builtin_amdgcn_perm(q[1], q[0], 0x0c0c0400u) | __builtin_amdgcn_perm(q[3], q[2], 0x04000c0cu); }
                        *(u32x2*)(rowp + bj * HALF) = w; } }
        }
    }
};

__device__ __forceinline__ void row_rstd512(const float* ss, int row0, float (&rs)[2][4]) {
#pragma unroll
    for (int ai = 0; ai < 2; ++ai)
#pragma unroll
        for (int m = 0; m < 4; ++m) rs[ai][m] = 1.0f / sqrtf(ss[row0 + ai * HALF + m * 16] * (1.0f / 512.0f) + 1e-6f);
}
struct EpiUq {
    static constexpr bool PERM = true, AFTER_DRAIN = false, MID = false;
    bf16_t *QBN, *QBR; const float *cosR, *sinR, *ss;
    __device__ __forceinline__ void operator()(f32x4 (&acc)[2][2][4][2], const Unit& u, int wr, int wc, int fr, int fq) const {
        const int row0 = u.pm * BM + wr * 64 + fr, pn = u.pn;
        float rs[2][4]; row_rstd512(ss, row0, rs);
#pragma unroll
        for (int ai = 0; ai < 2; ++ai)
#pragma unroll
            for (int m = 0; m < 4; ++m)
#pragma unroll
                for (int bj = 0; bj < 2; ++bj)
#pragma unroll
                    for (int n = 0; n < 2; ++n) acc[ai][bj][m][n] = acc[ai][bj][m][n] * rs[ai][m];
        if (pn < 4) {
            const int col0 = pn * BM + wc * 32 + 8 * fq;
#pragma unroll
            for (int ai = 0; ai < 2; ++ai)
#pragma unroll
                for (int m = 0; m < 4; ++m) { bf16_t* rowp = QBN + (size_t)(row0 + ai * HALF + m * 16) * 2048 + col0;
#pragma unroll
                    for (int bj = 0; bj < 2; ++bj) *(u32x4*)(rowp + bj * HALF) = pack8(acc[ai][bj][m][0], acc[ai][bj][m][1]); }
        } else {
            const int head = 4 * (pn - 4) + wc, d0 = 8 * fq;
#pragma unroll
            for (int ai = 0; ai < 2; ++ai)
#pragma unroll
                for (int m = 0; m < 4; ++m) { const size_t row = (size_t)(row0 + ai * HALF + m * 16); bf16_t* o1 = QBR + row * 512 + head * 64 + d0;
                    rope_store<32>(acc, ai, m, cosR, sinR, row, d0, o1, o1 + 32); }
        }
    }
};
struct EpiScaledBf16 {
    static constexpr bool PERM = true, AFTER_DRAIN = false, MID = false;
    bf16_t* O; int ldc; const float* ss;
    __device__ __forceinline__ void operator()(const f32x4 (&acc)[2][2][4][2], const Unit& u, int wr, int wc, int fr, int fq) const {
        const int row0 = u.pm * BM + wr * 64 + fr, col0 = u.pn * BM + wc * 32 + 8 * fq;
        float rs[2][4]; row_rstd512(ss, row0, rs);
#pragma unroll
        for (int ai = 0; ai < 2; ++ai)
#pragma unroll
            for (int m = 0; m < 4; ++m) { bf16_t* rowp = O + (size_t)(row0 + ai * HALF + m * 16) * ldc + col0;
#pragma unroll
                for (int bj = 0; bj < 2; ++bj) *(u32x4*)(rowp + bj * HALF) = pack8(acc[ai][bj][m][0] * rs[ai][m], acc[ai][bj][m][1] * rs[ai][m]); }
    }
};

struct EpiGateMerge {
    static constexpr bool PERM = true, AFTER_DRAIN = false, MID = MERGE_MID;
    const unsigned char* G; bf16_t* O;
    static __device__ __forceinline__ f32x4 ub4(unsigned w) { return (f32x4){(float)(w & 0xffu), (float)((w >> 8) & 0xffu), (float)((w >> 16) & 0xffu), (float)(w >> 24)}; }
    __device__ __forceinline__ void mid(f32x4 (&acc)[2][2][4][2], const Unit& u, int wr, int wc, int fr_, int fq_) const {
        int fr = fr_, fq = fq_; asm volatile("" : "+v"(fr), "+v"(fq));
        const int row0 = u.pm * BM + wr * 64 + fr, col0 = u.pn * BM + wc * 32 + 8 * fq;
#pragma unroll
        for (int ai = 0; ai < 2; ++ai) {
            u32x2 ga[4][2], gb[4][2];
#pragma unroll
            for (int m = 0; m < 4; ++m) { const unsigned char* gp = G + (size_t)(row0 + ai * HALF + m * 16) * 4096 + col0;
#pragma unroll
                for (int bj = 0; bj < 2; ++bj) { ga[m][bj] = *(const u32x2*)(gp + bj * HALF); gb[m][bj] = *(const u32x2*)(gp + 2048 + bj * HALF); } }
#pragma unroll
            for (int m = 0; m < 4; ++m)
#pragma unroll
                for (int bj = 0; bj < 2; ++bj) { const u32x2 A = ga[m][bj], Bv = gb[m][bj];
                    const f32x4 a0 = ub4(A.x), a1 = ub4(A.y);
                    f32x4 b0 = ub4(Bv.x), b1 = ub4(Bv.y);
#pragma unroll
                    for (int i = 0; i < 4; ++i) { b0[i] = fmaxf(b0[i], 1e-30f); b1[i] = fmaxf(b1[i], 1e-30f); }
#pragma unroll
                    for (int i = 0; i < 4; ++i) { acc[ai][bj][m][0][i] *= a0[i] * __builtin_amdgcn_rcpf(b0[i]); acc[ai][bj][m][1][i] *= a1[i] * __builtin_amdgcn_rcpf(b1[i]); } }
            asm volatile("" ::: "memory");
        }
    }
    __device__ __forceinline__ void operator()(const f32x4 (&acc)[2][2][4][2], const Unit& u, int wr, int wc, int fr, int fq) const {
        const int row0 = u.pm * BM + wr * 64 + fr, col0 = u.pn * BM + wc * 32 + 8 * fq;
#pragma unroll
        for (int ai = 0; ai < 2; ++ai)
#pragma unroll
            for (int m = 0; m < 4; ++m) { const size_t row = (size_t)(row0 + ai * HALF + m * 16);
#pragma unroll
                for (int bj = 0; bj < 2; ++bj) { const int col = col0 + bj * HALF; const u32x2 gb = *(const u32x2*)(G + row * 4096 + 2048 + col);
                    f32x4 g0 = ub4(gb.x), g1 = ub4(gb.y);
#pragma unroll
                    for (int i = 0; i < 4; ++i) { g0[i] = fmaxf(g0[i], 1e-30f) * (1.0f / 255.0f); g1[i] = fmaxf(g1[i], 1e-30f) * (1.0f / 255.0f); }
                    const f32x4 v0 = acc[ai][bj][m][0] * g0, v1 = acc[ai][bj][m][1] * g1;
                    *(u32x4*)(O + row * 2048 + col) = pack8(v0, v1); } }
    }
};
template <class Epi, class Sched, bool ALIGN_EPI = false, bool SP2 = false>
__device__ __forceinline__ void gemm_phase(PG8_LAS unsigned char* lds, const Gemm g, const Sched& S, const Epi& E, const int wave_s) {
    int tid_ = wave_s * 64 + lane_id_fresh(); asm volatile("" : "+v"(tid_));
    const int tid = tid_, wid = __builtin_amdgcn_readfirstlane(tid >> 6), lane = tid & 63, wr = wid >> 2, wc = wid & 3, fr = lane & 15, fq = lane >> 4;
    const int K = g.K, nt = K / BK;
    unsigned voffA[2], voffB[2];
#pragma unroll
    for (int i = 0; i < 2; ++i) { int R, C; stage_rc(tid * 16 + i * 8192, R, C); const int Rb = Epi::PERM ? ((R & ~31) + perm32(R & 31)) : R;
        voffA[i] = (unsigned)(R * K + C) * 2u; voffB[i] = (unsigned)(Rb * K + C) * 2u; }
    const size_t kstep = (size_t)(BK * 2);
    const size_t hstep = (size_t)HALF * K * 2;
    const size_t tstep = 2 * hstep;
    const unsigned ldsw = (unsigned)wid * 1024u;
    const int aoff = lds_byte(wr * 64 + fr, fq * 8), boff = lds_byte(wc * 32 + fr, fq * 8);
#define PG8_SA(b, h) (((b) * 2 + (h)) * HTB)
#define PG8_SB(b, h) ((4 + (b) * 2 + (h)) * HTB)
#define PG8_STAGE(bufoff, gbase, voff) do { _Pragma("unroll") for (int _i = 0; _i < 2; ++_i) \
        __builtin_amdgcn_global_load_lds((const unsigned*)((const char*)(gbase) + (voff)[_i]), (PG8_LAS unsigned*)(lds + (bufoff) + ldsw + _i * 8192), 16, 0, 0); } while (0)
#define PG8_LDA(dst, b, h) do { _Pragma("unroll") for (int m = 0; m < 4; ++m) _Pragma("unroll") for (int k = 0; k < 2; ++k) dst[m][k] = *(const PG8_LAS bf16x8*)(lds + PG8_SA(b, h) + aoff + m * 2048 + k * 1024); } while (0)
#define PG8_LDB(dst, b, h) do { _Pragma("unroll") for (int n = 0; n < 2; ++n) _Pragma("unroll") for (int k = 0; k < 2; ++k) dst[n][k] = *(const PG8_LAS bf16x8*)(lds + PG8_SB(b, h) + boff + n * 2048 + k * 1024); } while (0)
#define PG8_MMA(ai, bj, At, Bt) do { __builtin_amdgcn_s_setprio(1); _Pragma("unroll") for (int m = 0; m < 4; ++m) _Pragma("unroll") for (int n = 0; n < 2; ++n) _Pragma("unroll") for (int k = 0; k < 2; ++k) \
        acc[ai][bj][m][n] = __builtin_amdgcn_mfma_f32_16x16x32_bf16(Bt[n][k], At[m][k], acc[ai][bj][m][n], 0, 0, 0); __builtin_amdgcn_s_setprio(0); } while (0)
#define PG8_WAIT_V(n) asm volatile("s_waitcnt vmcnt(" #n ")" ::: "memory")
#define PG8_WAIT_L(n) asm volatile("s_waitcnt lgkmcnt(" #n ")" ::: "memory")
#define PG8_BAR __builtin_amdgcn_s_barrier()
#define PG8_SCHED __builtin_amdgcn_sched_barrier(0)
    Unit cur, nxt; int ui = 0;
    if (!S.next(0, cur)) return;
    f32x4 acc[2][2][4][2];
#pragma unroll
    for (int a = 0; a < 2; ++a)
#pragma unroll
        for (int b = 0; b < 2; ++b)
#pragma unroll
            for (int m = 0; m < 4; ++m)
#pragma unroll
                for (int n = 0; n < 2; ++n) acc[a][b][m][n] = (f32x4){0.f, 0.f, 0.f, 0.f};
    bf16x8 At[4][2], B0[2][2], B1[2][2];
    const char* cA = (const char*)g.A + (size_t)cur.pm * tstep; const char* cB = (const char*)g.Bt + (size_t)cur.pn * tstep;
    S.a_ready(cur);
    if constexpr (SP2) {
        PG8_STAGE(PG8_SB(0, 0), cB, voffB); PG8_STAGE(PG8_SB(0, 1), cB + hstep, voffB); PG8_STAGE(PG8_SA(0, 0), cA, voffA); PG8_STAGE(PG8_SA(0, 1), cA + hstep, voffA);
        if (wr == 1) PG8_BAR;
        PG8_WAIT_V(2); PG8_BAR;
        PG8_STAGE(PG8_SB(1, 0), cB + kstep, voffB); PG8_STAGE(PG8_SA(1, 0), cA + kstep, voffA); PG8_STAGE(PG8_SB(1, 1), cB + hstep + kstep, voffB);
        PG8_WAIT_V(6); PG8_BAR;
    } else {
        PG8_STAGE(PG8_SB(0, 0), cB, voffB); PG8_STAGE(PG8_SA(0, 0), cA, voffA); PG8_STAGE(PG8_SB(0, 1), cB + hstep, voffB); PG8_STAGE(PG8_SA(0, 1), cA + hstep, voffA);
        if (wr == 1) PG8_BAR;
        PG8_WAIT_V(4); PG8_BAR;
        PG8_STAGE(PG8_SB(1, 0), cB + kstep, voffB); PG8_STAGE(PG8_SA(1, 0), cA + kstep, voffA); PG8_STAGE(PG8_SB(1, 1), cB + hstep + kstep, voffB);
        PG8_WAIT_V(6); PG8_BAR;
    }
    for (;;) {
        const bool has_next = S.next(ui + 1, nxt);
        const char* nA = has_next ? (const char*)g.A + (size_t)nxt.pm * tstep : cA; const char* nB = has_next ? (const char*)g.Bt + (size_t)nxt.pn * tstep : cB;
        for (int t = 0; t < nt; t += 2) {
            const bool last = (t == nt - 2);
            const char* a1 = cA + (size_t)(t + 1) * kstep;
            const char* a2 = last ? nA : cA + (size_t)(t + 2) * kstep; const char* b2 = last ? nB : cB + (size_t)(t + 2) * kstep;
            const char* a3 = a2 + kstep; const char* b3 = b2 + kstep;
            if (last && has_next) S.a_ready(nxt);
            if constexpr (SP2) {
            PG8_LDB(B0, 0, 0); PG8_LDB(B1, 0, 1); PG8_SCHED; PG8_LDA(At, 0, 0); PG8_STAGE(PG8_SA(1, 1), a1 + hstep, voffA);
            PG8_WAIT_V(8); PG8_WAIT_L(0); PG8_BAR; PG8_MMA(0, 0, At, B0); PG8_MMA(0, 1, At, B1); PG8_BAR; PG8_SCHED;
            PG8_LDA(At, 0, 1); PG8_STAGE(PG8_SB(0, 0), b2, voffB); PG8_STAGE(PG8_SB(0, 1), b2 + hstep, voffB); PG8_STAGE(PG8_SA(0, 0), a2, voffA);
            PG8_WAIT_V(8); PG8_WAIT_L(0); PG8_BAR; PG8_MMA(1, 0, At, B0); PG8_MMA(1, 1, At, B1); PG8_BAR; PG8_SCHED;
            PG8_LDB(B0, 1, 0); PG8_LDB(B1, 1, 1); PG8_SCHED; PG8_LDA(At, 1, 0); PG8_STAGE(PG8_SA(0, 1), a2 + hstep, voffA);
            PG8_WAIT_V(8); PG8_WAIT_L(0); PG8_BAR; PG8_MMA(0, 0, At, B0); PG8_MMA(0, 1, At, B1); PG8_BAR; PG8_SCHED;
            PG8_LDA(At, 1, 1); PG8_STAGE(PG8_SB(1, 0), b3, voffB); PG8_STAGE(PG8_SB(1, 1), b3 + hstep, voffB); PG8_STAGE(PG8_SA(1, 0), a3, voffA);
            PG8_WAIT_V(8); PG8_WAIT_L(0); PG8_BAR; PG8_MMA(1, 0, At, B0); PG8_MMA(1, 1, At, B1); PG8_BAR; PG8_SCHED;
            } else {
            PG8_LDB(B0, 0, 0); PG8_SCHED; PG8_LDA(At, 0, 0); PG8_STAGE(PG8_SA(1, 1), a1 + hstep, voffA);
            PG8_WAIT_L(8); PG8_BAR; PG8_WAIT_L(0); PG8_MMA(0, 0, At, B0); PG8_BAR; PG8_SCHED;
            PG8_LDB(B1, 0, 1); PG8_STAGE(PG8_SB(0, 0), b2, voffB);
            PG8_BAR; PG8_WAIT_L(0); PG8_MMA(0, 1, At, B1); PG8_BAR;
            PG8_LDA(At, 0, 1); PG8_STAGE(PG8_SA(0, 0), a2, voffA);
            PG8_BAR; PG8_WAIT_L(0); PG8_MMA(1, 0, At, B0); PG8_BAR; PG8_SCHED;
            PG8_STAGE(PG8_SB(0, 1), b2 + hstep, voffB);
            PG8_WAIT_V(6); PG8_BAR; PG8_MMA(1, 1, At, B1); PG8_BAR;
            PG8_LDB(B0, 1, 0); PG8_SCHED; PG8_LDA(At, 1, 0); PG8_STAGE(PG8_SA(0, 1), a2 + hstep, voffA);
            PG8_WAIT_L(8); PG8_BAR; PG8_WAIT_L(0); PG8_MMA(0, 0, At, B0); PG8_BAR; PG8_SCHED;
            PG8_LDB(B1, 1, 1); PG8_STAGE(PG8_SB(1, 0), b3, voffB);
            PG8_BAR; PG8_WAIT_L(0); PG8_MMA(0, 1, At, B1); PG8_BAR;
            PG8_LDA(At, 1, 1); PG8_STAGE(PG8_SA(1, 0), a3, voffA);
            PG8_BAR; PG8_WAIT_L(0); PG8_MMA(1, 0, At, B0); PG8_BAR; PG8_SCHED;
            PG8_STAGE(PG8_SB(1, 1), b3 + hstep, voffB);
            PG8_WAIT_V(6); PG8_BAR; PG8_MMA(1, 1, At, B1); PG8_BAR;
            }
            if constexpr (Epi::MID) { if (t == nt / 2 - 2) { PG8_SCHED; E.mid(acc, cur, wr, wc, fr, fq); PG8_SCHED; } }
        }
        if constexpr (ALIGN_EPI) { if (wr == 0) PG8_BAR; }
        if constexpr (!Epi::AFTER_DRAIN) { E(acc, cur, wr, wc, fr, fq); S.done(cur); }
        if (!has_next) break;
#pragma unroll
        for (int a = 0; a < 2; ++a)
#pragma unroll
            for (int b = 0; b < 2; ++b)
#pragma unroll
                for (int m = 0; m < 4; ++m)
#pragma unroll
                    for (int n = 0; n < 2; ++n) acc[a][b][m][n] = (f32x4){0.f, 0.f, 0.f, 0.f};
        cur = nxt; cA = nA; cB = nB; ++ui;
        if constexpr (ALIGN_EPI) { if (wr == 1) PG8_BAR; }
    }
    PG8_WAIT_V(0);
    if constexpr (!ALIGN_EPI) { if (wr == 0) PG8_BAR; }
    PG8_BAR;
    if constexpr (Epi::AFTER_DRAIN) { E.fused(acc, cur, wr, wc, fr, fq, lds, wid, lane); S.done(cur); }
#undef PG8_SA
#undef PG8_SB
#undef PG8_STAGE
#undef PG8_LDA
#undef PG8_LDB
#undef PG8_MMA
#undef PG8_WAIT_V
#undef PG8_WAIT_L
#undef PG8_BAR
#undef PG8_SCHED
}
}
namespace att {
typedef unsigned short bf16;
using bf16x8 = __attribute__((ext_vector_type(8))) short;
using s16x4  = __attribute__((ext_vector_type(4))) short;
using f32x16 = __attribute__((ext_vector_type(16))) float;
using u32x4  = __attribute__((ext_vector_type(4))) unsigned;
using f32x2  = __attribute__((ext_vector_type(2))) float;
constexpr int NW = 8, QBLK = 32, KVBLK = 64;
constexpr int SHM_V = KVBLK * 128 * 2, SHM_K = KVBLK * 128 * 2, SHM_KR = KVBLK * 64 * 2;
constexpr int O3_V = 0, O3_K = 3 * SHM_V, O3_KR = O3_K + 3 * SHM_K, O3_WS = O3_KR + 3 * SHM_KR, O3_QR = O3_WS + NW * 64 * 4, ATT3_LDS = O3_QR + NW * 4096;
#define KSWZ(row, colB) ((row) * 256 + ((colB) ^ (((row) & 15) << 4)))
#define KRSWZ(row, colB) ((row) * 128 + ((colB) ^ ((((row) >> 1) & 7) << 4)))
#define SBAR() __builtin_amdgcn_sched_barrier(0)
__device__ __forceinline__ int crow(int r, int hi) { return (r & 3) + 8 * (r >> 2) + 4 * hi; }
typedef __bf16 bf16x2_t __attribute__((ext_vector_type(2)));
__device__ __forceinline__ unsigned cvtpk(float lo, float hi) { const float __attribute__((ext_vector_type(2))) v = {lo, hi}; return __builtin_bit_cast(unsigned, __builtin_convertvector(v, bf16x2_t)); }

template <bool MASK> __device__ __forceinline__ void partialSM(f32x16& p0, f32x16& p1, float& m_reg, float& mn, float& alpha, const float C, const float THRR, int qi, int kb, int hi) {
  if (MASK) {
    int t = qi - 128 - kb - 4 * hi; asm volatile("" : "+v"(t));
#pragma unroll
    for (int r = 0; r < 16; ++r) { const int cr = (r & 3) + 8 * (r >> 2);
      p0[r] = ((unsigned)(cr - t) <= 256u) ? p0[r] : -__builtin_inff();
      p1[r] = ((unsigned)(cr + 32 - t) <= 256u) ? p1[r] : -__builtin_inff(); }
  }
  float pmax = p0[0];
#pragma unroll
  for (int r = 1; r < 16; ++r) pmax = fmaxf(pmax, p0[r]);
#pragma unroll
  for (int r = 0; r < 16; ++r) pmax = fmaxf(pmax, p1[r]);
  { auto rr = __builtin_amdgcn_permlane32_swap(__float_as_uint(pmax), __float_as_uint(pmax), false, false);
    pmax = fmaxf(__uint_as_float(rr[0]), __uint_as_float(rr[1])); }
  if (__builtin_expect(__all(pmax - m_reg <= THRR), 1)) { mn = m_reg; alpha = 1.f; }
  else { mn = fmaxf(m_reg, pmax); alpha = __builtin_amdgcn_exp2f((m_reg - mn) * C); m_reg = mn; }
  const float mnC = -mn * C; const f32x2 C2 = {C, C}, mnC2 = {mnC, mnC};
#pragma unroll
  for (int r = 0; r < 16; r += 2) { const f32x2 t = __builtin_elementwise_fma((f32x2){p0[r], p0[r + 1]}, C2, mnC2); p0[r] = t.x; p0[r + 1] = t.y; }
#pragma unroll
  for (int r = 0; r < 16; r += 2) { const f32x2 t = __builtin_elementwise_fma((f32x2){p1[r], p1[r + 1]}, C2, mnC2); p1[r] = t.x; p1[r + 1] = t.y; }
#pragma unroll
  for (int r = 0; r < 16; ++r) p0[r] = __builtin_amdgcn_exp2f(p0[r]);
}
__device__ __forceinline__ void finishSM(f32x16& p0, f32x16& p1, float alpha, float& l_reg, bf16x8& pa0, bf16x8& pa1, bf16x8& pa2, bf16x8& pa3) {
#pragma unroll
  for (int r = 0; r < 16; ++r) p1[r] = __builtin_amdgcn_exp2f(p1[r]);
  f32x2 ps2 = {p0[0], p0[1]};
#pragma unroll
  for (int r = 2; r < 16; r += 2) ps2 += (f32x2){p0[r], p0[r + 1]};
#pragma unroll
  for (int r = 0; r < 16; r += 2) ps2 += (f32x2){p1[r], p1[r + 1]};
  float ps = ps2.x + ps2.y;
  { auto rr = __builtin_amdgcn_permlane32_swap(__float_as_uint(ps), __float_as_uint(ps), false, false);
    ps = __uint_as_float(rr[0]) + __uint_as_float(rr[1]); }
  l_reg = l_reg * alpha + ps;
#define PK4(P, BASE, OUT) do { unsigned a0 = cvtpk(P[BASE + 0], P[BASE + 1]), a1 = cvtpk(P[BASE + 2], P[BASE + 3]);   \
    unsigned b0 = cvtpk(P[BASE + 4], P[BASE + 5]), b1 = cvtpk(P[BASE + 6], P[BASE + 7]);                              \
    auto r0 = __builtin_amdgcn_permlane32_swap(a0, b0, false, false); auto r1 = __builtin_amdgcn_permlane32_swap(a1, b1, false, false); \
    u32x4 w = {r0[0], r1[0], r0[1], r1[1]}; OUT = *reinterpret_cast<bf16x8*>(&w); } while (0)
  PK4(p0, 0, pa0); PK4(p0, 8, pa1); PK4(p1, 0, pa2); PK4(p1, 8, pa3);
#undef PK4
}
template <int NR> __device__ __forceinline__ void qkt(f32x16& p0, f32x16& p1, const char* Ks, const char* KRs, const bf16x8* qr, const char* qrl, int r32, int hi) {
  p0 = f32x16{}; p1 = f32x16{};
#pragma unroll
  for (int d0 = 0; d0 < 8; ++d0) { const int cb = (d0 * 16 + hi * 8) * 2;
    const bf16x8 b0 = *reinterpret_cast<const bf16x8*>(Ks + KSWZ(r32, cb));
    const bf16x8 b1 = *reinterpret_cast<const bf16x8*>(Ks + KSWZ(32 + r32, cb));
    p0 = __builtin_amdgcn_mfma_f32_32x32x16_bf16(b0, qr[d0], p0, 0, 0, 0);
    p1 = __builtin_amdgcn_mfma_f32_32x32x16_bf16(b1, qr[d0], p1, 0, 0, 0); }
#pragma unroll
  for (int d0 = 0; d0 < NR; ++d0) { const int cb = (d0 * 16 + hi * 8) * 2;
    const bf16x8 b0 = *reinterpret_cast<const bf16x8*>(KRs + KRSWZ(r32, cb));
    const bf16x8 b1 = *reinterpret_cast<const bf16x8*>(KRs + KRSWZ(32 + r32, cb));
    const bf16x8 qf = *reinterpret_cast<const bf16x8*>(qrl + d0 * 1024);
    p0 = __builtin_amdgcn_mfma_f32_32x32x16_bf16(b0, qf, p0, 0, 0, 0);
    p1 = __builtin_amdgcn_mfma_f32_32x32x16_bf16(b1, qf, p1, 0, 0, 0); }
}
__device__ __forceinline__ int v_st(int k, int c) { const int kk = (k & ~0xC) | ((k & 4) << 1) | ((k & 8) >> 1); return ((kk >> 3) * 4 + (c >> 5)) * 512 + ((kk & 7) * 32 + (c & 31)) * 2; }
__device__ __forceinline__ int v_rd_base(int lane) { return ((lane & 3) << 3) | (((lane >> 2) & 3) << 6) | (((lane >> 4) & 1) << 5) | (((lane >> 5) & 1) << 8); }
constexpr int v_rd_off(int d0, int ks, int half) { return d0 * 512 + ks * 4096 + half * 2048; }
template <int OFF> __device__ __forceinline__ s16x4 tr_read(int vb) { s16x4 r; asm volatile("ds_read_b64_tr_b16 %0, %1 offset:%2" : "=&v"(r) : "v"(vb), "i"(OFF) : "memory"); return r; }
template <int D0> __device__ __forceinline__ void pv_one(f32x16& od, int vb, bf16x8 pa0, bf16x8 pa1, bf16x8 pa2, bf16x8 pa3) {
  const s16x4 l0 = tr_read<v_rd_off(D0, 0, 0)>(vb), h0 = tr_read<v_rd_off(D0, 0, 1)>(vb), l1 = tr_read<v_rd_off(D0, 1, 0)>(vb), h1 = tr_read<v_rd_off(D0, 1, 1)>(vb);
  const s16x4 l2 = tr_read<v_rd_off(D0, 2, 0)>(vb), h2 = tr_read<v_rd_off(D0, 2, 1)>(vb), l3 = tr_read<v_rd_off(D0, 3, 0)>(vb), h3 = tr_read<v_rd_off(D0, 3, 1)>(vb);
  asm volatile("s_waitcnt lgkmcnt(0)" ::: "memory"); SBAR();
#define PK(L, H) (bf16x8){L[0], L[1], L[2], L[3], H[0], H[1], H[2], H[3]}
  od = __builtin_amdgcn_mfma_f32_32x32x16_bf16(pa0, PK(l0, h0), od, 0, 0, 0);
  od = __builtin_amdgcn_mfma_f32_32x32x16_bf16(pa1, PK(l1, h1), od, 0, 0, 0);
  od = __builtin_amdgcn_mfma_f32_32x32x16_bf16(pa2, PK(l2, h2), od, 0, 0, 0);
  od = __builtin_amdgcn_mfma_f32_32x32x16_bf16(pa3, PK(l3, h3), od, 0, 0, 0);
#undef PK
}
__device__ __forceinline__ void pv_d0(f32x16* o, int vb, bf16x8 pa0, bf16x8 pa1, bf16x8 pa2, bf16x8 pa3) {
  pv_one<0>(o[0], vb, pa0, pa1, pa2, pa3); pv_one<1>(o[1], vb, pa0, pa1, pa2, pa3); pv_one<2>(o[2], vb, pa0, pa1, pa2, pa3); pv_one<3>(o[3], vb, pa0, pa1, pa2, pa3);
}

__device__ __forceinline__ void glds16(const void* gsrc, unsigned lds_dst) {
  unsigned keep; asm volatile("s_mov_b32 %0, m0\n\ts_mov_b32 m0, %2\n\ts_nop 0\n\tglobal_load_lds_dwordx4 %1, off\n\ts_mov_b32 m0, %0" : "=&s"(keep) : "v"(gsrc), "s"(lds_dst) : "memory"); }
template <bool MLA, int LDQ, int LDQR, int LDK>
__device__ __forceinline__ void attn_body_dma(const bf16* Qb, const bf16* Qrb, const bf16* __restrict__ Kh, const bf16* __restrict__ Vh, const bf16* __restrict__ KRh,
                                              bf16* Ob, int NT, const float C, const float THRR, const float m0, const float l0, int q0, int kb0, char* lds, const int wave_s) {
  constexpr int NR = MLA ? 4 : 0;
  int tid_ = wave_s * 64 + lane_id_fresh(); asm volatile("" : "+v"(tid_));
  const int tid = tid_, wid = tid >> 6, lane = tid & 63, r32 = lane & 31, hi = lane >> 5;
  char* V_lds = lds + O3_V; char* K_lds = lds + O3_K; char* KR_lds = lds + O3_KR;
  float* wsf = (float*)(lds + O3_WS) + wid * 64; float* li_l = wsf; float* al_l = wsf + 32;
  float m_reg = m0, l_reg = l0; f32x16 o[4] = {}; bf16x8 qr[8];
  const bf16* Qw = Qb + (long)(wid * QBLK + r32) * LDQ + hi * 8;
#pragma unroll
  for (int d0 = 0; d0 < 8; ++d0) qr[d0] = *reinterpret_cast<const bf16x8*>(Qw + d0 * 16);
  const char* qrl = lds + O3_QR + wid * 4096 + lane * 16;
  if (MLA) { const bf16* Qrw = Qrb + (long)(wid * QBLK + r32) * LDQR + hi * 8;
#pragma unroll
    for (int d0 = 0; d0 < NR; ++d0) *(bf16x8*)(lds + O3_QR + wid * 4096 + lane * 16 + d0 * 1024) = *reinterpret_cast<const bf16x8*>(Qrw + d0 * 16); }
  const int qi = q0 + wid * QBLK + r32;
  const int vb0 = (int)(uintptr_t)V_lds + v_rd_base(lane);
  unsigned offK[2], offV[2], offKR;
#pragma unroll
  for (int i = 0; i < 2; ++i) { const int B = (2 * wid + i) * 1024 + 16 * lane;
    { const int row = B >> 8, pc = (B >> 4) & 15; offK[i] = (unsigned)(row * LDK * 2 + ((pc ^ (row & 15)) << 4)); }
    { const int s_ = B >> 9, o_ = B & 511, kk = (s_ >> 2) * 8 + (o_ >> 6), c = (s_ & 3) * 32 + ((o_ & 63) >> 1), k = (kk & ~0xC) | ((kk & 4) << 1) | ((kk & 8) >> 1);
      offV[i] = (unsigned)(k * LDK * 2 + c * 2); } }
  { const int B = wid * 1024 + 16 * lane, row = B >> 7, pc = (B >> 4) & 7; offKR = (unsigned)(row * 128 + ((pc ^ ((row >> 1) & 7)) << 4)); }
  const unsigned ldsb = (unsigned)__builtin_amdgcn_readfirstlane((int)(uintptr_t)lds);
  const unsigned ldsV = ldsb + O3_V + 2 * wave_s * 1024, ldsK = ldsb + O3_K + 2 * wave_s * 1024, ldsKR = ldsb + O3_KR + wave_s * 1024;
#define DMA_TILE(t, b) do { const size_t tb_ = (size_t)(t) * (KVBLK * LDK * 2); \
    glds16((const char*)Kh + tb_ + offK[0], ldsK + (b) * SHM_K); glds16((const char*)Kh + tb_ + offK[1], ldsK + (b) * SHM_K + 1024); \
    glds16((const char*)Vh + tb_ + offV[0], ldsV + (b) * SHM_V); glds16((const char*)Vh + tb_ + offV[1], ldsV + (b) * SHM_V + 1024); \
    if (MLA) glds16((const char*)KRh + (size_t)(t) * (KVBLK * 128) + offKR, ldsKR + (b) * SHM_KR); } while (0)
#define PUBLISH() asm volatile("s_waitcnt vmcnt(0)\n\ts_barrier" ::: "memory")
#define RESC3(a) do { if (__any((a) < 1.f)) { if (hi == 0) al_l[r32] = (a); asm volatile("s_waitcnt lgkmcnt(0)" ::: "memory"); \
    _Pragma("unroll") for (int d = 0; d < 4; ++d) _Pragma("unroll") for (int r = 0; r < 16; ++r) o[d][r] *= al_l[crow(r, hi)]; } } while (0)
  f32x16 pA0, pA1, pB0, pB1; float mnA, mnB, alA, alB; bf16x8 pa0, pa1, pa2, pa3;
  DMA_TILE(0, 0); DMA_TILE(1, 1); asm volatile("s_waitcnt lgkmcnt(0)" ::: "memory"); PUBLISH();
  qkt<NR>(pA0, pA1, K_lds, KR_lds, qr, qrl, r32, hi); partialSM<!MLA>(pA0, pA1, m_reg, mnA, alA, C, THRR, qi, kb0, hi);
  int bprev = 0, bcur = 1, bnext = 2;
#define ROT3() do { const int t_ = bprev; bprev = bcur; bcur = bnext; bnext = t_; } while (0)
  for (int j = 1; j + 1 < NT; j += 2) {
    DMA_TILE(j + 1, bnext);
    SBAR(); qkt<NR>(pB0, pB1, K_lds + bcur * SHM_K, KR_lds + bcur * SHM_KR, qr, qrl, r32, hi);
    finishSM(pA0, pA1, alA, l_reg, pa0, pa1, pa2, pa3); SBAR();
    pv_d0(o, vb0 + bprev * SHM_V, pa0, pa1, pa2, pa3); partialSM<!MLA>(pB0, pB1, m_reg, mnB, alB, C, THRR, qi, kb0 + j * KVBLK, hi);
    RESC3(alB); PUBLISH(); ROT3();
    DMA_TILE(j + 2, bnext);
    SBAR(); qkt<NR>(pA0, pA1, K_lds + bcur * SHM_K, KR_lds + bcur * SHM_KR, qr, qrl, r32, hi);
    finishSM(pB0, pB1, alB, l_reg, pa0, pa1, pa2, pa3); SBAR();
    pv_d0(o, vb0 + bprev * SHM_V, pa0, pa1, pa2, pa3); partialSM<!MLA>(pA0, pA1, m_reg, mnA, alA, C, THRR, qi, kb0 + (j + 1) * KVBLK, hi);
    RESC3(alA); PUBLISH(); ROT3();
  }
  SBAR(); qkt<NR>(pB0, pB1, K_lds + bcur * SHM_K, KR_lds + bcur * SHM_KR, qr, qrl, r32, hi);
  finishSM(pA0, pA1, alA, l_reg, pa0, pa1, pa2, pa3); SBAR();
  pv_d0(o, vb0 + bprev * SHM_V, pa0, pa1, pa2, pa3); partialSM<!MLA>(pB0, pB1, m_reg, mnB, alB, C, THRR, qi, kb0 + (NT - 1) * KVBLK, hi);
  RESC3(alB);
  finishSM(pB0, pB1, alB, l_reg, pa0, pa1, pa2, pa3); SBAR();
  pv_d0(o, vb0 + bcur * SHM_V, pa0, pa1, pa2, pa3);
  if (hi == 0) li_l[r32] = l_reg; asm volatile("s_waitcnt lgkmcnt(0)" ::: "memory");
  float rli[16];
#pragma unroll
  for (int r = 0; r < 16; ++r) rli[r] = __builtin_amdgcn_rcpf(li_l[crow(r, hi)]);
  bf16* Ow = Ob + (long)(wid * QBLK) * LDQ;
#pragma unroll
  for (int r = 0; r < 16; ++r) { const int orow = crow(r, hi);
#pragma unroll
    for (int d0 = 0; d0 < 4; ++d0) { const float v = o[d0][r] * rli[r]; Ow[(long)orow * LDQ + d0 * 32 + r32] = (bf16)(cvtpk(v, v) & 0xffffu); } }
  asm volatile("s_waitcnt vmcnt(0) lgkmcnt(0)\n\ts_barrier" ::: "memory");
#undef DMA_TILE
#undef PUBLISH
#undef RESC3
#undef ROT3
}
#undef KSWZ
#undef KRSWZ
#undef SBAR
}
constexpr int NWAVES = 8;
constexpr int NB = 8, SEQ = 4096, M = NB * SEQ, D = 2048, FF = 5632, DEPTH = 2, NMOD = 9 * D, WIN_SRC = 6720, WIN_N = 6912;
constexpr float EPS = 1e-6f;
constexpr size_t MiB = 1u << 20;
constexpr size_t WS_CTL = 0, WS_MOD = 1 * MiB, WS_SS = 2 * MiB + 256 * 1024  , WS_ZERO_BYTES = 3 * MiB;
constexpr size_t WS_COSA = 4 * MiB, WS_SINA = 12 * MiB, WS_COSR = 20 * MiB, WS_SINR = 24 * MiB;
constexpr size_t WS_W = 28 * MiB;
constexpr size_t LW_GU1 = 0, LW_D1 = LW_GU1 + (size_t)2 * FF * D, LW_GU2 = LW_D1 + (size_t)FF * D, LW_D2 = LW_GU2 + (size_t)2 * FF * D, LW_IN = LW_D2 + (size_t)FF * D,
                 LW_UQ = LW_IN + (size_t)WIN_N * D, LW_UKV = LW_UQ + (size_t)1536 * 512, LW_OA = LW_UKV + (size_t)2048 * 512, LW_OB = LW_OA + (size_t)2048 * 1024,
                 LW_OUT = LW_OB + (size_t)2048 * 1024, LW_ELEMS = LW_OUT + (size_t)2048 * 2048;
static_assert(LW_ELEMS == 93585408, "weight map");
constexpr size_t WS_X16 = WS_W + ((2 * LW_ELEMS * 2 + MiB - 1) / MiB) * MiB;
constexpr size_t WS_BIG = WS_X16 + 128 * MiB;
constexpr size_t B_QA = 0  ,
                 B_KA = 128 * MiB, B_VA = 144 * MiB, B_CQN = 160 * MiB, B_CKVN = 192 * MiB, B_KR = 224 * MiB, B_GATES = 232 * MiB, B_QBR = 488 * MiB, B_KVB = 520 * MiB, B_END = 648 * MiB;
constexpr size_t B_ACT = 0, B_DELTA = 352 * MiB  ;
constexpr size_t WS_END = WS_BIG + B_END;
static_assert((size_t)M * FF * 2 <= B_END && WS_X16 == 385 * MiB, "d_ws map");
constexpr int CW_BAR = 4096;
constexpr int LDS_BYTES = 163840, LDSCTL_OFF = 162816, SCR_OFF = 65536, SCR_WAVE = 8448;
static_assert(SCR_OFF + NWAVES * SCR_WAVE <= LDSCTL_OFF && att::ATT3_LDS <= LDSCTL_OFF, "LDS map");

#define GAS __attribute__((address_space(1)))
#define LAS __attribute__((address_space(3)))
typedef unsigned short bf16;
typedef unsigned v4u __attribute__((ext_vector_type(4)));
typedef unsigned v2u __attribute__((ext_vector_type(2)));
typedef float f32x4 __attribute__((ext_vector_type(4)));
typedef _Float16 h16x4 __attribute__((ext_vector_type(4)));
#define LDS_WAIT() asm volatile("s_waitcnt lgkmcnt(0)" ::: "memory")
#define VM_WAIT() asm volatile("s_waitcnt vmcnt(0)" ::: "memory")
__device__ __forceinline__ unsigned f2bf(float f) { unsigned u = __builtin_bit_cast(unsigned, f); return (u + 0x7fffu + ((u >> 16) & 1u)) >> 16; }
__device__ __forceinline__ unsigned pk2(float lo, float hi) { return f2bf(lo) | (f2bf(hi) << 16); }
template <int CTRL> __device__ __forceinline__ float dpp_add(float v) { return v + __int_as_float(__builtin_amdgcn_update_dpp(0, __float_as_int(v), CTRL, 0xf, 0xf, true)); }
__device__ __forceinline__ float wave_sum(float v) {
    v = dpp_add<0xB1>(v);
    v = dpp_add<0x4E>(v);
    v = dpp_add<0x141>(v);
    v = dpp_add<0x140>(v);
    { auto r = __builtin_amdgcn_permlane16_swap(__float_as_uint(v), __float_as_uint(v), false, false); v = __uint_as_float(r[0]) + __uint_as_float(r[1]); }
    { auto r = __builtin_amdgcn_permlane32_swap(__float_as_uint(v), __float_as_uint(v), false, false); v = __uint_as_float(r[0]) + __uint_as_float(r[1]); }
    return v;
}
#define XB_TMO      128
#define XB_XCNT(j)  (256  + 64 * (j))
#define XB_XSUB(j)  (1280 + 64 * (j))
#define XB_XGEN(j)  (2304 + 64 * (j))
#define XB_TOP      3328
#define XB_TOPGEN   3392
#define XCD_BAR_WORDS 3456
#define XB_SPIN_CAP (1u << 18)

__device__ __forceinline__ unsigned xb_ld(unsigned* p)              { return __hip_atomic_load(p, __ATOMIC_RELAXED, __HIP_MEMORY_SCOPE_AGENT); }
__device__ __forceinline__ unsigned xb_add(unsigned* p, unsigned v) { return __hip_atomic_fetch_add(p, v, __ATOMIC_RELAXED, __HIP_MEMORY_SCOPE_AGENT); }
__device__ __forceinline__ unsigned xb_xcc_id() { return (unsigned)__builtin_amdgcn_s_getreg((3 << 11) | 20) & 0xFu; }
#define XB_SPIN(cond, bar) do { unsigned _sp = 0; while (cond) { __builtin_amdgcn_s_sleep(1); \
    if ((++_sp & 255u) == 0u) { if (xb_ld(&(bar)[XB_TMO])) break; if (_sp > XB_SPIN_CAP) { atomicAdd(&(bar)[XB_TMO], 1u); break; } } } } while (0)

struct XcdBarrier {
    unsigned* bar; unsigned x;
    unsigned wv;
    volatile LAS unsigned* st;
};

__device__ __forceinline__ XcdBarrier xcd_barrier_post(unsigned* bar, volatile LAS unsigned* st) {
    XcdBarrier b; b.bar = bar; b.x = xb_xcc_id(); b.st = st; b.wv = (unsigned)__builtin_amdgcn_readfirstlane(threadIdx.x >> 6);
    if (threadIdx.x == 0) (void)xb_add(&bar[XB_XCNT(b.x)], 1u);
    return b;
}
__device__ __forceinline__ void xcd_barrier_complete(unsigned* bar, unsigned x, unsigned& nloc, unsigned& nx) {
    const unsigned G = gridDim.x * gridDim.y * gridDim.z;
    unsigned sum, cnt, mine, sp = 0u;
    for (;;) {
        sum = 0u; cnt = 0u; mine = 0u;
#pragma unroll
        for (unsigned j = 0; j < 16; ++j) { const unsigned c = xb_ld(&bar[XB_XCNT(j)]); sum += c; cnt += (c > 0u) ? 1u : 0u; mine = (j == x) ? c : mine; }
        if (sum == G) break;
        __builtin_amdgcn_s_sleep(1);
        if ((++sp & 255u) == 0u) { if (xb_ld(&bar[XB_TMO])) break; if (sp > XB_SPIN_CAP) { atomicAdd(&bar[XB_TMO], 1u); break; } }
    }
    nloc = mine > 0u ? mine : 1u; nx = cnt > 0u ? cnt : 1u;
}

__device__ __forceinline__ void xcd_barrier(const XcdBarrier& b) {
    asm volatile("s_waitcnt vmcnt(0)" ::: "memory");
    __syncthreads();
    if (b.wv == 0u && lane_id_fresh() == 0) {
        unsigned* bar = b.bar;
        __builtin_amdgcn_s_waitcnt(0);
        unsigned nloc = b.st[0], nx = b.st[1];
        if (nloc == 0u) { xcd_barrier_complete(bar, b.x, nloc, nx); b.st[0] = nloc; b.st[1] = nx; }
        const unsigned old = xb_add(&bar[XB_XSUB(b.x)], 1u);
        const unsigned gen = old / nloc;
        if (old + 1u == (gen + 1u) * nloc) {
            __builtin_amdgcn_fence(__ATOMIC_RELEASE, "agent");
            asm volatile("s_waitcnt vmcnt(0)" ::: "memory");
            const unsigned og = xb_add(&bar[XB_TOP], 1u);
            const unsigned tg = og / nx;
            if (og + 1u == (tg + 1u) * nx) xb_add(&bar[XB_TOPGEN], 1u);
            else XB_SPIN(xb_ld(&bar[XB_TOPGEN]) == tg, bar);
            __builtin_amdgcn_fence(__ATOMIC_ACQUIRE, "agent");
            xb_add(&bar[XB_XGEN(b.x)], 1u);
            asm volatile("s_waitcnt vmcnt(0)" ::: "memory");
        } else {
            XB_SPIN(xb_ld(&bar[XB_XGEN(b.x)]) == gen, bar);
            __builtin_amdgcn_fence(__ATOMIC_ACQUIRE, "agent");
            asm volatile("s_waitcnt vmcnt(0)" ::: "memory");
        }
    }
    __syncthreads();
}
#define LOCAL_IDS() int tid_ = wave_s * 64 + lane_id_fresh(); asm volatile("" : "+v"(tid_)); const int lane = tid_ & 63, gw = vcu * NWAVES + __builtin_amdgcn_readfirstlane(tid_ >> 6), NGW = G * NWAVES
__device__ __forceinline__ int map_col(int map, int n) {
    if (map == 0) return n;
    if (map == 1) { const int t = n >> 8, j = n & 255; return j < 128 ? 128 * t + j : FF + 128 * t + (j - 128); }
    if (map == 2) {
        const int t = n >> 8, j = n & 255, bj = j >> 7, jj = j & 127;
        if (t < 4) return (2 * t + (jj >> 6)) * 128 + (jj & 63) + 64 * bj;
        if (t == 4) return 1024 + (jj >> 6) * 128 + (jj & 63) + 64 * bj;
        if (t == 5) return 1280 + j;
        if (t < 10) return 1536 + (t - 6) * 256 + j;
        if (t == 10) return jj < 32 ? 2560 + bj * 32 + jj : -1;
        return 2624 + (t - 11) * 256 + j;
    }
    {
        if (n < 1024) return (n >> 7) * 192 + (n & 127);
        const int t = (n >> 8) - 4, j = n & 255, bj = j >> 7, jj = j & 127;
        return (4 * t + (jj >> 5)) * 192 + 128 + (jj & 31) + 32 * bj;
    }
}
__device__ __forceinline__ void tr_item(const float* W, int K, int Nsrc, int Ndst, bf16* WT, int map, LAS float* scr, int item, int lane, int ldt = 0) {
    const int nblk = Ndst >> 5, kb = item / nblk, nb = item - kb * nblk, k0 = 64 * kb, n0 = 32 * nb;
    const int src = map_col(map, n0 + (lane & 31));
    const float* wp = W + (size_t)(k0 + (lane >> 5)) * Nsrc + (src < 0 ? 0 : src);
    float tv[32];
#pragma unroll
    for (int i = 0; i < 32; ++i) tv[i] = wp[(size_t)(2 * i) * Nsrc];
#pragma unroll
    for (int i = 0; i < 32; ++i) scr[(2 * i + (lane >> 5)) * 33 + (lane & 31)] = src < 0 ? 0.f : tv[i];
    LDS_WAIT(); asm volatile("" ::: "memory");
    const int c = lane & 7;
#pragma unroll
    for (int j = 0; j < 4; ++j) { const int n = (lane >> 3) + 8 * j; const LAS float* s = scr + (8 * c) * 33 + n;
        v4u o; o.x = pk2(s[0 * 33], s[1 * 33]); o.y = pk2(s[2 * 33], s[3 * 33]); o.z = pk2(s[4 * 33], s[5 * 33]); o.w = pk2(s[6 * 33], s[7 * 33]);
        *(v4u*)(WT + (size_t)(n0 + n) * (ldt ? ldt : K) + k0 + 8 * c) = o; }
    LDS_WAIT(); asm volatile("" ::: "memory");
}
__device__ __forceinline__ void sincos_d(float angf, float& s_out, float& c_out) {
    const double a = (double)angf;
    const double q = __builtin_rint(a * 0.63661977236758134308);
    double t = __builtin_fma(-q, 1.57079632679489655800, a); t = __builtin_fma(-q, 6.12323399573676603587e-17, t);
    const double t2 = t * t;
    double sp = 1.0 / 6227020800.0; sp = sp * t2 - 1.0 / 39916800.0; sp = sp * t2 + 1.0 / 362880.0; sp = sp * t2 - 1.0 / 5040.0; sp = sp * t2 + 1.0 / 120.0; sp = sp * t2 - 1.0 / 6.0; sp = sp * t2 + 1.0; sp = sp * t;
    double cp = -1.0 / 87178291200.0; cp = cp * t2 + 1.0 / 479001600.0; cp = cp * t2 - 1.0 / 3628800.0; cp = cp * t2 + 1.0 / 40320.0; cp = cp * t2 - 1.0 / 720.0; cp = cp * t2 + 1.0 / 24.0; cp = cp * t2 - 0.5; cp = cp * t2 + 1.0;
    const int qi = ((int)(long long)q) & 3;
    const double s = (qi == 0) ? sp : (qi == 1) ? cp : (qi == 2) ? -sp : -cp;
    const double c = (qi == 0) ? cp : (qi == 1) ? -sp : (qi == 2) ? -cp : sp;
    s_out = (float)s; c_out = (float)c;
}

struct P {
    const float *x, *c, *norm_g, *w_ada, *b_ada, *w_gu1, *w_d1, *w_gu2, *w_d2, *w_in, *b_gate, *sink, *g_cq, *g_ckv, *w_uq, *w_ukv, *w_oa, *w_ob, *w_out, *g_final;
    const int* pos; float* out; unsigned char* ws;
};

__device__ __forceinline__ void prologue(const P& p, LAS unsigned char* lds, int vcu, int G, const bool skip_ada, const int wave_s) {
    LOCAL_IDS(); const int tid = tid_, wave = __builtin_amdgcn_readfirstlane(tid_ >> 6);
    LAS float* cact = (LAS float*)lds;
    for (int i = tid; i < NB * D; i += NWAVES * 64) { const int b = i >> 11, k = i & 2047; const float cv = p.c[i]; cact[k * 8 + b] = cv / (1.0f + expf(-cv)); }
    __syncthreads();
    LAS float* scr = (LAS float*)(lds + SCR_OFF + wave * SCR_WAVE);
    float* mod = (float*)(p.ws + WS_MOD);
    constexpr int I_ADA = DEPTH * 72 * 8, I_TAB = M / 16;
    constexpr int I_GU = 32 * 352, I_D = 88 * 64, I_IN = 32 * (WIN_N / 32), I_UQ = 8 * 48, I_UKV = 8 * 64, I_O = 16 * 64, I_OUT = 32 * 64;
    constexpr int I_LAYER = 2 * I_GU + 2 * I_D + I_IN + I_UQ + I_UKV + 2 * I_O + I_OUT;
    constexpr int NITEMS = I_ADA + I_TAB + DEPTH * I_LAYER;
    for (int it = gw; it < NITEMS; it += NGW) {
        int r = it;
        if (r < I_ADA) { if (skip_ada) continue;
            const int l = r / 576, rr = r - l * 576, cg = rr >> 3, kc = rr & 7;
            const float* W = p.w_ada + ((size_t)l * D + 256 * kc) * NMOD + 256 * cg + 4 * lane;
            f32x4 acc[8];
#pragma unroll
            for (int b = 0; b < 8; ++b) acc[b] = (f32x4){0.f, 0.f, 0.f, 0.f};
            for (int k = 0; k < 256; k += 16) {
                f32x4 w[16];
#pragma unroll
                for (int kk = 0; kk < 16; ++kk) w[kk] = *(const f32x4*)(W + (size_t)(k + kk) * NMOD);
#pragma unroll
                for (int kk = 0; kk < 16; ++kk) { const LAS f32x4* cp = (const LAS f32x4*)(cact + (256 * kc + k + kk) * 8); const f32x4 c0 = cp[0], c1 = cp[1];
                    acc[0] += w[kk] * c0[0]; acc[1] += w[kk] * c0[1]; acc[2] += w[kk] * c0[2]; acc[3] += w[kk] * c0[3];
                    acc[4] += w[kk] * c1[0]; acc[5] += w[kk] * c1[1]; acc[6] += w[kk] * c1[2]; acc[7] += w[kk] * c1[3]; }
            }
            if (kc == 0) { const f32x4 bv = *(const f32x4*)(p.b_ada + (size_t)l * NMOD + 256 * cg + 4 * lane);
#pragma unroll
                for (int b = 0; b < 8; ++b) acc[b] += bv; }
#pragma unroll
            for (int b = 0; b < 8; ++b) { float* dst = mod + (size_t)(l * 8 + b) * NMOD + 256 * cg + 4 * lane;
#pragma unroll
                for (int i = 0; i < 4; ++i) unsafeAtomicAdd(dst + i, acc[b][i]); }
            continue;
        }
        r -= I_ADA;
        if (r < I_TAB) {
            const double ea = -(double)lane * (1.0 / 64.0), er = -(double)(lane & 31) * (1.0 / 32.0);
            const float fa = (float)exp2(ea * 13.287712379549449), fr = (float)exp2(er * 13.287712379549449);
            float* cosA = (float*)(p.ws + WS_COSA); float* sinA = (float*)(p.ws + WS_SINA); float* cosR = (float*)(p.ws + WS_COSR); float* sinR = (float*)(p.ws + WS_SINR);
            for (int i = 0; i < 16; ++i) { const int m = 16 * r + i; const float pf = (float)p.pos[m];
                float s, c; sincos_d(pf * fa, s, c); cosA[(size_t)m * 64 + lane] = c; sinA[(size_t)m * 64 + lane] = s;
                if (lane < 32) { sincos_d(pf * fr, s, c); cosR[(size_t)m * 32 + lane] = c; sinR[(size_t)m * 32 + lane] = s; } }
            continue;
        }
        r -= I_TAB;
        const int l = r >= I_LAYER ? 1 : 0; r -= l * I_LAYER;
        bf16* wl = (bf16*)(p.ws + WS_W) + (size_t)l * LW_ELEMS;
        if (r < I_GU) { tr_item(p.w_gu1 + (size_t)l * D * 2 * FF, D, 2 * FF, 2 * FF, wl + LW_GU1, 1, scr, r, lane); continue; } r -= I_GU;
        if (r < I_D)  { tr_item(p.w_d1 + (size_t)l * FF * D, FF, D, D, wl + LW_D1, 0, scr, r, lane); continue; } r -= I_D;
        if (r < I_GU) { tr_item(p.w_gu2 + (size_t)l * D * 2 * FF, D, 2 * FF, 2 * FF, wl + LW_GU2, 1, scr, r, lane); continue; } r -= I_GU;
        if (r < I_D)  { tr_item(p.w_d2 + (size_t)l * FF * D, FF, D, D, wl + LW_D2, 0, scr, r, lane); continue; } r -= I_D;
        if (r < I_IN) { tr_item(p.w_in + (size_t)l * D * WIN_SRC, D, WIN_SRC, WIN_N, wl + LW_IN, 2, scr, r, lane); continue; } r -= I_IN;
        if (r < I_UQ) { tr_item(p.w_uq + (size_t)l * 512 * 1536, 512, 1536, 1536, wl + LW_UQ, 3, scr, r, lane); continue; } r -= I_UQ;
        if (r < I_UKV) { tr_item(p.w_ukv + (size_t)l * 512 * 2048, 512, 2048, 2048, wl + LW_UKV, 0, scr, r, lane); continue; } r -= I_UKV;
        if (r < I_O)  { tr_item(p.w_oa + (size_t)l * 1024 * 2048, 1024, 2048, 2048, wl + LW_OA, 0, scr, r, lane, 2048); continue; } r -= I_O;
        if (r < I_O)  { tr_item(p.w_ob + (size_t)l * 1024 * 2048, 1024, 2048, 2048, wl + LW_OA + 1024, 0, scr, r, lane, 2048); continue; } r -= I_O;
        tr_item(p.w_out + (size_t)l * 2048 * 2048, 2048, 2048, 2048, wl + LW_OUT, 0, scr, r, lane);
    }
}

template <bool DELTA, bool FINAL, bool XI16 = false, bool XO16 = false>
__device__ __forceinline__ void thin_phase(const void* xin_, void* xout_, const bf16* delta, const float* gate, float coef, const float* g, const float* sh, const float* sc, bf16* H, int vcu, int G, const int wave_s) {
    LOCAL_IDS();
    unsigned lo16 = (unsigned)lane * 16u, lo8 = (unsigned)lane * 8u;
#define LD16(base, j) (*(const f32x4*)((const char*)(base) + lo16 + (unsigned)(j) * 1024u))
#define ST16(base, j, v) (*(f32x4*)((char*)(base) + lo16 + (unsigned)(j) * 1024u) = (v))
#define LD8(base, j) (*(const v2u*)((const char*)(base) + lo8 + (unsigned)(j) * 512u))
#define ST8(base, j, v) (*(v2u*)((char*)(base) + lo8 + (unsigned)(j) * 512u) = (v))
    for (int blk = gw; blk < M / 16; blk += NGW) {
        const int row0 = blk * 16, b = row0 >> 12;
        const float* scb = sc + (size_t)b * NMOD; const float* shb = sh + (size_t)b * NMOD; const float* gtb = gate + (size_t)b * NMOD;
        f32x4 ca[8], cs[8], cg[8];
#pragma unroll
        for (int j = 0; j < 8; ++j) { const f32x4 gv = LD16(g, j);
            if (FINAL) { ca[j] = gv; cs[j] = (f32x4){0.f, 0.f, 0.f, 0.f}; }
            else { ca[j] = gv * (LD16(scb, j) + 1.0f); cs[j] = LD16(shb, j); }
            if (DELTA) cg[j] = LD16(gtb, j) * coef; }
        for (int i = 0; i < 16; i += 2) {
            asm volatile("" : "+v"(lo16), "+v"(lo8));
            const size_t r0 = (size_t)(row0 + i) * D;
            f32x4 v0[8], v1[8]; float ss0 = 0.f, ss1 = 0.f;
            if (XI16) { const _Float16* x0 = (const _Float16*)xin_ + r0; const _Float16* x1 = x0 + D; v2u a0[8], a1[8];
#pragma unroll
                for (int j = 0; j < 8; ++j) { a0[j] = LD8(x0, j); a1[j] = LD8(x1, j); }
#pragma unroll
                for (int j = 0; j < 8; ++j) { v0[j] = __builtin_convertvector(__builtin_bit_cast(h16x4, a0[j]), f32x4); v1[j] = __builtin_convertvector(__builtin_bit_cast(h16x4, a1[j]), f32x4); } }
            else { const float* x0 = (const float*)xin_ + r0; const float* x1 = x0 + D;
#pragma unroll
                for (int j = 0; j < 8; ++j) { v0[j] = LD16(x0, j); v1[j] = LD16(x1, j); } }
            if (!DELTA && XO16 && !FINAL) { _Float16* xo0 = (_Float16*)xout_ + r0; _Float16* xo1 = xo0 + D;
#pragma unroll
                for (int j = 0; j < 8; ++j) { ST8(xo0, j, __builtin_bit_cast(v2u, __builtin_convertvector(v0[j], h16x4))); ST8(xo1, j, __builtin_bit_cast(v2u, __builtin_convertvector(v1[j], h16x4))); } }
            if (DELTA) { const bf16* dl0 = delta + r0; const bf16* dl1 = dl0 + D; v2u d0[8], d1[8];
#pragma unroll
                for (int j = 0; j < 8; ++j) { d0[j] = LD8(dl0, j); d1[j] = LD8(dl1, j); }
#pragma unroll
                for (int j = 0; j < 8; ++j) {
                    v0[j] = v0[j] + cg[j] * (f32x4){__uint_as_float(d0[j].x << 16), __uint_as_float(d0[j].x & 0xffff0000u), __uint_as_float(d0[j].y << 16), __uint_as_float(d0[j].y & 0xffff0000u)};
                    v1[j] = v1[j] + cg[j] * (f32x4){__uint_as_float(d1[j].x << 16), __uint_as_float(d1[j].x & 0xffff0000u), __uint_as_float(d1[j].y << 16), __uint_as_float(d1[j].y & 0xffff0000u)}; }
                if (!FINAL && XO16) { _Float16* xo0 = (_Float16*)xout_ + r0; _Float16* xo1 = xo0 + D;
#pragma unroll
                    for (int j = 0; j < 8; ++j) { ST8(xo0, j, __builtin_bit_cast(v2u, __builtin_convertvector(v0[j], h16x4))); ST8(xo1, j, __builtin_bit_cast(v2u, __builtin_convertvector(v1[j], h16x4))); } }
                if (!FINAL && !XO16) { float* xo0 = (float*)xout_ + r0; float* xo1 = xo0 + D;
#pragma unroll
                    for (int j = 0; j < 8; ++j) { ST16(xo0, j, v0[j]); ST16(xo1, j, v1[j]); } } }
#pragma unroll
            for (int j = 0; j < 8; ++j) { ss0 += (v0[j].x * v0[j].x + v0[j].y * v0[j].y) + (v0[j].z * v0[j].z + v0[j].w * v0[j].w); ss1 += (v1[j].x * v1[j].x + v1[j].y * v1[j].y) + (v1[j].z * v1[j].z + v1[j].w * v1[j].w); }
            const float rstd0 = 1.0f / sqrtf(wave_sum(ss0) * (1.0f / D) + EPS), rstd1 = 1.0f / sqrtf(wave_sum(ss1) * (1.0f / D) + EPS);
            if (FINAL) { float* xo0 = (float*)xout_ + r0; float* xo1 = xo0 + D;
#pragma unroll
                for (int j = 0; j < 8; ++j) { ST16(xo0, j, v0[j] * rstd0 * ca[j]); ST16(xo1, j, v1[j] * rstd1 * ca[j]); } }
            else { bf16* h0p = H + r0; bf16* h1p = h0p + D;
#pragma unroll
                for (int j = 0; j < 8; ++j) { const f32x4 h0 = v0[j] * rstd0 * ca[j] + cs[j], h1 = v1[j] * rstd1 * ca[j] + cs[j]; v2u w0, w1; w0.x = pk2(h0.x, h0.y); w0.y = pk2(h0.z, h0.w); w1.x = pk2(h1.x, h1.y); w1.y = pk2(h1.z, h1.w); ST8(h0p, j, w0); ST8(h1p, j, w1); } }
        }
    }
#undef LD16
#undef ST16
#undef LD8
#undef ST8
}
#ifndef EN_PRO
#define EN_PRO 1
#endif
#ifndef EN_ATT
#define EN_ATT 1
#endif
#ifndef EN_G1
#define EN_G1 1
#endif
#ifndef EN_G2
#define EN_G2 1
#endif
#ifndef EN_G4
#define EN_G4 1
#endif
#ifndef EN_G6
#define EN_G6 1
#endif
#ifndef EN_G8
#define EN_G8 1
#endif
#ifndef EN_G9
#define EN_G9 1
#endif
#ifndef EN_G11
#define EN_G11 1
#endif
#ifndef EN_G12
#define EN_G12 1
#endif
struct Args { const void* in[21]; float* out; unsigned char* ws; int ph_lo, ph_hi; };
#ifndef ALIGN_WIN
#define ALIGN_WIN true
#endif
#ifndef GEMM_ALIGN
#define GEMM_ALIGN true
#endif
#ifndef GEMM_SP2
#define GEMM_SP2 true
#endif
#ifndef WGM_S
#define WGM_S 8
#endif
#ifndef REV_D
#define REV_D 0
#endif
#ifndef WGM_GU
#define WGM_GU 8
#endif
#ifndef WGM_WIN
#define WGM_WIN 8
#endif
#ifndef WGM_D
#define WGM_D 4
#endif
#ifndef FCH
#define FCH 1
#endif
constexpr int MC = M / FCH;
enum { P_N1 = 0, P_F1 = 1, P_N2 = P_F1 + FCH + 1, P_WIN, P_UQ, P_ATT, P_OAB, P_WOUT, P_N3, P_F2, PH_PER_LAYER = P_F2 + FCH + 1 };
constexpr int N_PHASES = 2 + DEPTH * PH_PER_LAYER;

__global__ void __launch_bounds__(NWAVES * 64, 2) mega_fwd(Args args) {
    extern __shared__ __attribute__((aligned(16))) unsigned char lds_raw[];
    LAS unsigned char* lds = (LAS unsigned char*)lds_raw;
    const int tid = threadIdx.x; const int wave_s = __builtin_amdgcn_readfirstlane(tid >> 6);
    const int G = gridDim.x, bx = blockIdx.x, vcu = (G % 8 == 0) ? (bx % 8) * (G / 8) + bx / 8 : bx;
    P p;
    p.x = (const float*)args.in[0]; p.c = (const float*)args.in[1]; p.pos = (const int*)args.in[2]; p.norm_g = (const float*)args.in[3]; p.w_ada = (const float*)args.in[4]; p.b_ada = (const float*)args.in[5];
    p.w_gu1 = (const float*)args.in[6]; p.w_d1 = (const float*)args.in[7]; p.w_gu2 = (const float*)args.in[8]; p.w_d2 = (const float*)args.in[9]; p.w_in = (const float*)args.in[10]; p.b_gate = (const float*)args.in[11];
    p.sink = (const float*)args.in[12]; p.g_cq = (const float*)args.in[13]; p.g_ckv = (const float*)args.in[14]; p.w_uq = (const float*)args.in[15]; p.w_ukv = (const float*)args.in[16];
    p.w_oa = (const float*)args.in[17]; p.w_ob = (const float*)args.in[18]; p.w_out = (const float*)args.in[19]; p.g_final = (const float*)args.in[20];
    p.out = args.out; p.ws = args.ws;
    unsigned char* ws = args.ws;
    for (int u = tid; u < (LDS_BYTES - LDSCTL_OFF) / 4; u += NWAVES * 64) ((LAS unsigned*)(lds + LDSCTL_OFF))[u] = 0u;
    __syncthreads();
    const int lo = args.ph_lo, hi = args.ph_hi;
    XcdBarrier bar; bar.bar = (unsigned*)(ws + WS_CTL) + CW_BAR; bar.x = 0; bar.st = nullptr;
    if (hi - lo > 1) bar = xcd_barrier_post((unsigned*)(ws + WS_CTL) + CW_BAR, (volatile LAS unsigned*)(lds + LDSCTL_OFF) + 8);
#define IN(k) (lo <= (k) && (k) < hi)
#define SEAM(k) do { if (IN(k) && IN((k) + 1)) xcd_barrier(bar); } while (0)

#define WSL() ({ unsigned long long w_ = (unsigned long long)ws; asm volatile("" : "+s"(w_)); (unsigned char*)(GAS unsigned char*)w_; })
#define mod   ((float*)(WSL() + WS_MOD))
#define cosA  ((const float*)(WSL() + WS_COSA))
#define sinA  ((const float*)(WSL() + WS_SINA))
#define cosR  ((const float*)(WSL() + WS_COSR))
#define sinR  ((const float*)(WSL() + WS_SINR))
#define H     ((bf16*)p.out)
#define X16   ((_Float16*)(WSL() + WS_X16))
#define big   (WSL() + WS_BIG)
#define ACT   ((bf16*)(big + B_ACT))
#define QA    ((bf16*)(big + B_QA))
#define KA    ((bf16*)(big + B_KA))
#define VA    ((bf16*)(big + B_VA))
#define CQN   ((bf16*)(big + B_CQN))
#define CKVN  ((bf16*)(big + B_CKVN))
#define KR    ((bf16*)(big + B_KR))
#define GATES ((unsigned char*)(big + B_GATES))
#define QBN   ((bf16*)(big + B_QA) + 1024)
#define QBR   ((bf16*)(big + B_QBR))
#define KVB   ((bf16*)(big + B_KVB))
#define MIX   H
#define DELTA ((bf16*)(big + B_DELTA))
#define SSQ   ((float*)(WSL() + WS_SS) + (size_t)(2 * l) * M)
#define SSKV  ((float*)(WSL() + WS_SS) + (size_t)(2 * l + 1) * M)

    if (EN_PRO && IN(0)) { prologue(p, lds, vcu, G, false, wave_s); VM_WAIT(); __syncthreads();
    }
    SEAM(0);

#pragma unroll 1
    for (int l = 0; l < DEPTH; ++l) {
        const int pb = 1 + l * PH_PER_LAYER;
#define wl ((const bf16*)(WSL() + WS_W) + (size_t)l * LW_ELEMS)
#define ml (mod + (size_t)l * 8 * NMOD)
        const float* ng = p.norm_g + (size_t)l * 3 * D;
        if (IN(pb + P_N1)) { if (l == 0) thin_phase<false, false, false, true>(p.x, X16, DELTA, ml, 0.f, ng, ml + 0 * D, ml + 1 * D, H, vcu, G, wave_s);
                             else thin_phase<false, false, true, false>(X16, X16, DELTA, ml, 0.f, ng, ml + 0 * D, ml + 1 * D, H, vcu, G, wave_s); }
        SEAM(pb + P_N1);
#pragma unroll 1
        for (int s_ = 0; s_ <= FCH; ++s_) {
            if (IN(pb + P_F1 + s_)) {
                if (s_ > 0) { const int c_ = s_ - 1; pg8::Gemm g{ACT + (size_t)c_ * MC * FF, wl + LW_D1, MC, D, FF}; pg8::StaticOrder S; S.init(MC, D, G, bx, WGM_D); S.rev = REV_D;
                    pg8::EpiResid16 E{X16 + (size_t)c_ * MC * D, ml + 2 * D + (size_t)((c_ * MC) >> 12) * NMOD, NMOD, 0.5f};
                    pg8::gemm_phase<pg8::EpiResid16, pg8::StaticOrder, GEMM_ALIGN, GEMM_SP2>(lds, g, S, E, wave_s); }
                if (s_ < FCH) { const int c_ = s_; pg8::Gemm g{H + (size_t)c_ * MC * D, wl + LW_GU1, MC, 2 * FF, D}; pg8::StaticOrder S; S.init(MC, 2 * FF, G, bx, WGM_GU); pg8::EpiSwiglu E{ACT + (size_t)c_ * MC * FF, FF};
                    pg8::gemm_phase<pg8::EpiSwiglu, pg8::StaticOrder, GEMM_ALIGN, GEMM_SP2>(lds, g, S, E, wave_s); }
            }
            SEAM(pb + P_F1 + s_);
        }
        if (IN(pb + P_N2)) thin_phase<false, false, true, false>(X16, X16, DELTA, ml, 0.f, ng + D, ml + 3 * D, ml + 4 * D, H, vcu, G, wave_s);
        SEAM(pb + P_N2);
        if (IN(pb + P_WIN)) { pg8::Gemm g{H, wl + LW_IN, M, WIN_N, D}; pg8::StaticOrder S; S.init(M, WIN_N, G, bx, WGM_WIN);
            pg8::EpiWin E{QA, KA, VA, KR, GATES, CQN, CKVN, SSQ, SSKV, p.g_cq + l * 512, p.g_ckv + l * 512, cosA, sinA, cosR, sinR, p.b_gate + (size_t)l * 2 * D};
            pg8::gemm_phase<pg8::EpiWin, pg8::StaticOrder, ALIGN_WIN, GEMM_SP2>(lds, g, S, E, wave_s); }
        SEAM(pb + P_WIN);
        if (IN(pb + P_UQ)) {
            { pg8::Gemm g{CQN, wl + LW_UQ, M, 1536, 512}; pg8::StaticOrder S; S.init(M, 1536, G, bx); pg8::EpiUq E{QBN, QBR, cosR, sinR, SSQ};
              pg8::gemm_phase<pg8::EpiUq, pg8::StaticOrder, GEMM_ALIGN, GEMM_SP2>(lds, g, S, E, wave_s); }
            { pg8::Gemm g{CKVN, wl + LW_UKV, M, 2048, 512}; pg8::StaticOrder S; S.init(M, 2048, G, bx, WGM_S); pg8::EpiScaledBf16 E{KVB, 2048, SSKV};
              pg8::gemm_phase<pg8::EpiScaledBf16, pg8::StaticOrder, GEMM_ALIGN, GEMM_SP2>(lds, g, S, E, wave_s); }
        }
        SEAM(pb + P_UQ);
        if (IN(pb + P_ATT)) {
            for (int u = vcu; u < NB * 8 * 16; u += G) { const int bh = u >> 4, qb = u & 15, b = bh >> 3, h = bh & 7; const size_t r0 = (size_t)b * SEQ + qb * 256, k0 = (size_t)b * SEQ;
                att::attn_body_dma<true, 2048, 512, 2048>(QBN + r0 * 2048 + h * 128, QBR + r0 * 512 + h * 64, KVB + k0 * 2048 + h * 256, KVB + k0 * 2048 + h * 256 + 128, KR + k0 * 64,
                                                      QBN + r0 * 2048 + h * 128, SEQ / 64, 0.07216878364870322f * 1.4426950408889634f, 8.0f / 0.07216878364870322f, -1e30f, 0.f, 0, 0, (char*)lds_raw, wave_s); }
            for (int u = vcu; u < NB * 8 * 16; u += G) { const int bh = u >> 4, qb = u & 15, b = bh >> 3, h = bh & 7, i0 = qb * 256; const size_t r0 = (size_t)b * SEQ + i0;
                const int klo = i0 >= 128 ? i0 - 128 : 0, khi = i0 + 384 <= SEQ ? i0 + 384 : SEQ; const size_t k0 = (size_t)b * SEQ + klo;
                const float sk = p.sink[l * 8 + h];
                att::attn_body_dma<false, 2048, 512, 256>(QA + r0 * 2048 + h * 128, nullptr, KA + k0 * 256 + (h >> 2) * 128, VA + k0 * 256 + (h >> 2) * 128, nullptr,
                                                      QA + r0 * 2048 + h * 128, (khi - klo) / 64, 0.08838834764831845f * 1.4426950408889634f, 8.0f / 0.08838834764831845f, sk / 0.08838834764831845f, 1.f, i0, klo, (char*)lds_raw, wave_s); }
        }
        SEAM(pb + P_ATT);
        if (IN(pb + P_OAB)) { pg8::Gemm g{QA, wl + LW_OA, M, D, 2048}; pg8::StaticOrder S; S.init(M, D, G, bx, WGM_S); pg8::EpiGateMerge E{GATES, MIX};
            pg8::gemm_phase<pg8::EpiGateMerge, pg8::StaticOrder, GEMM_ALIGN, GEMM_SP2>(lds, g, S, E, wave_s); }
        SEAM(pb + P_OAB);
        if (IN(pb + P_WOUT)) { pg8::Gemm g{MIX, wl + LW_OUT, M, D, D}; pg8::StaticOrder S; S.init(M, D, G, bx, WGM_S); pg8::EpiResid16 E{X16, ml + 5 * D, NMOD, 1.0f};
            pg8::gemm_phase<pg8::EpiResid16, pg8::StaticOrder, GEMM_ALIGN, GEMM_SP2>(lds, g, S, E, wave_s); }
        SEAM(pb + P_WOUT);
        if (IN(pb + P_N3)) thin_phase<false, false, true, false>(X16, X16, DELTA, ml, 0.f, ng + 2 * D, ml + 6 * D, ml + 7 * D, H, vcu, G, wave_s);
        SEAM(pb + P_N3);
#pragma unroll 1
        for (int s_ = 0; s_ <= FCH; ++s_) {
            if (IN(pb + P_F2 + s_)) {
                if (s_ > 0) { const int c_ = s_ - 1; pg8::Gemm g{ACT + (size_t)c_ * MC * FF, wl + LW_D2, MC, D, FF}; pg8::StaticOrder S; S.init(MC, D, G, bx, WGM_D); S.rev = REV_D;
                    pg8::EpiResid16 E{X16 + (size_t)c_ * MC * D, ml + 8 * D + (size_t)((c_ * MC) >> 12) * NMOD, NMOD, 0.5f};
                    pg8::gemm_phase<pg8::EpiResid16, pg8::StaticOrder, GEMM_ALIGN, GEMM_SP2>(lds, g, S, E, wave_s); }
                if (s_ < FCH) { const int c_ = s_; pg8::Gemm g{H + (size_t)c_ * MC * D, wl + LW_GU2, MC, 2 * FF, D}; pg8::StaticOrder S; S.init(MC, 2 * FF, G, bx, WGM_GU); pg8::EpiSwiglu E{ACT + (size_t)c_ * MC * FF, FF};
                    pg8::gemm_phase<pg8::EpiSwiglu, pg8::StaticOrder, GEMM_ALIGN, GEMM_SP2>(lds, g, S, E, wave_s); }
            }
            SEAM(pb + P_F2 + s_);
        }
    }
    if (IN(N_PHASES - 1)) thin_phase<false, true, true, false>(X16, p.out, DELTA, mod, 0.f, p.g_final, p.g_final, p.g_final, H, vcu, G, wave_s);
#undef IN
#undef SEAM
}

extern "C" void kernel_launch(void* const* d_in, const int* in_sizes, int n_in, void* d_out, int out_size, void* d_ws, size_t ws_size, hipStream_t stream) {
    static int grid = 0;
    if (grid == 0) {
        if (n_in != 21 || in_sizes[0] != M * D || out_size != M * D || ws_size < WS_END) {
            fprintf(stderr, "kernel_launch: built for 21 inputs, x/out of %d floats, >= %zu bytes of workspace; got n_in %d, in0 %d, out %d, ws %zu; nothing launched\n", M * D, (size_t)WS_END, n_in, n_in > 0 ? in_sizes[0] : -1, out_size, ws_size);
            grid = -1; return; }
        int dev = 0, cus = 0, per_cu = 0;
        if (hipGetDevice(&dev) != hipSuccess || hipDeviceGetAttribute(&cus, hipDeviceAttributeMultiprocessorCount, dev) != hipSuccess) { fprintf(stderr, "kernel_launch: device query failed\n"); grid = -1; return; }
        if (hipFuncSetAttribute((const void*)mega_fwd, hipFuncAttributeMaxDynamicSharedMemorySize, LDS_BYTES) != hipSuccess) { fprintf(stderr, "kernel_launch: hipFuncSetAttribute failed\n"); grid = -1; return; }
        if (hipOccupancyMaxActiveBlocksPerMultiprocessor(&per_cu, (const void*)mega_fwd, NWAVES * 64, LDS_BYTES) != hipSuccess || per_cu < 1)
            fprintf(stderr, "kernel_launch: note: occupancy query reports %d workgroups per CU\n", per_cu);
        (void)hipGetLastError();
        grid = cus;
    }
    if (grid < 0) return;
    if (hipMemsetAsync((char*)d_ws + WS_CTL, 0, WS_ZERO_BYTES, stream) != hipSuccess) { fprintf(stderr, "kernel_launch: memset failed\n"); return; }
    Args a{};
    for (int i = 0; i < 21; ++i) a.in[i] = d_in[i];
    a.out = (float*)d_out; a.ws = (unsigned char*)d_ws;
#if MK_ONE_LAUNCH
    a.ph_lo = 0; a.ph_hi = N_PHASES;
    hipLaunchKernelGGL(mega_fwd, dim3(grid), dim3(NWAVES * 64), LDS_BYTES, stream, a);
#else
    for (int ph = 0; ph < N_PHASES; ++ph) { a.ph_lo = ph; a.ph_hi = ph + 1;
        hipLaunchKernelGGL(mega_fwd, dim3(grid), dim3(NWAVES * 64), LDS_BYTES, stream, a);
    }
#endif
    const hipError_t le = hipPeekAtLastError();
    if (le != hipSuccess) fprintf(stderr, "kernel_launch: launch failed: %s\n", hipGetErrorName(le));
}
```

```cpp
#include <hip/hip_runtime.h>
#include <cstdio>
#include <cstdint>
#include <cmath>

#ifndef MERGE_MID
#define MERGE_MID true
#endif
#ifndef MK_ONE_LAUNCH
#define MK_ONE_LAUNCH 1
#endif

__device__ __forceinline__ int lane_id_fresh() { int l; asm volatile("v_mbcnt_lo_u32_b32 %0, -1, 0\n\tv_mbcnt_hi_u32_b32 %0, -1, %0" : "=v"(l)); return l; }

namespace pg8 {
#define PG8_LAS __attribute__((address_space(3)))
typedef unsigned short bf16_t;
typedef short bf16x8 __attribute__((ext_vector_type(8)));
typedef float f32x4 __attribute__((ext_vector_type(4)));
typedef unsigned u32x4 __attribute__((ext_vector_type(4)));
constexpr int BM = 256, BK = 64, HALF = 128, HTB = HALF * BK * 2  , STAGE_BYTES = 8 * HTB, NXCD = 8, WGM = 8;

__host__ __device__ __forceinline__ int lds_byte(int r, int c) { const int st = (r >> 4) * 2 + (c >> 5), rr = r & 15, cc = c & 31, ob = rr * 64 + cc * 2; return st * 1024 + (ob ^ (((ob >> 9) & 1) << 5)); }
__host__ __device__ __forceinline__ void stage_rc(int b, int& R, int& C) { const int st = b / 1024, sb = b % 1024, swz = sb ^ (((sb >> 9) & 1) << 5); R = (st >> 1) * 16 + swz / 64; C = (st & 1) * 32 + (swz % 64) / 2; }
__host__ __device__ __forceinline__ int perm32(int rho) { const int n = rho >> 4, i = rho & 15; return 8 * (i >> 2) + 4 * n + (i & 3); }

struct Unit { int pm, pn; };
struct Gemm { const bf16_t* A; const bf16_t* Bt; int M, N, K; };

struct StaticOrder {
    int nM, nN, nwg, G, c, wgm, rev;
    int pad_;
    __host__ __device__ void init(int M, int N, int G_, int c_, int wgm_ = WGM) { nM = M / BM; nN = N / BM; nwg = nM * nN; G = G_; c = c_; wgm = wgm_; rev = 0; pad_ = 0; }
    __host__ __device__ bool next(int i, Unit& u) const {
        const long L = (long)i * G + c; if (L >= nwg) return false;
        int wgid = (int)L; { const int q = nwg / NXCD, r = nwg % NXCD, xcd = wgid % NXCD, off = wgid / NXCD; wgid = (xcd < r ? xcd * (q + 1) : r * (q + 1) + (xcd - r) * q) + off; }
        const int nig = wgm * nN, gid = wgid / nig, fm = gid * wgm, gsz = (nM - fm) < wgm ? (nM - fm) : wgm;
        u.pm = fm + ((wgid % nig) % gsz); u.pn = (wgid % nig) / gsz; if (rev) u.pm = nM - 1 - u.pm; return true;
    }
    __device__ __forceinline__ void a_ready(const Unit&) const {}
    __device__ __forceinline__ void done(const Unit&) const {}
};
typedef __bf16 bf16x2_t __attribute__((ext_vector_type(2)));
__device__ __forceinline__ unsigned cvt_pk_bf16(float lo, float hi) { const float __attribute__((ext_vector_type(2))) v = {lo, hi}; return __builtin_bit_cast(unsigned, __builtin_convertvector(v, bf16x2_t)); }
typedef float f32x2 __attribute__((ext_vector_type(2)));
typedef unsigned u32x2 __attribute__((ext_vector_type(2)));
__device__ __forceinline__ float bf_lo(unsigned w) { return __uint_as_float(w << 16); }
__device__ __forceinline__ float bf_hi(unsigned w) { return __uint_as_float(w & 0xffff0000u); }
__device__ __forceinline__ float fast_sigmoid(float x) { return __builtin_amdgcn_rcpf(1.0f + __builtin_amdgcn_exp2f(-1.4426950408889634f * x)); }
__device__ __forceinline__ f32x2 fast_sigmoid2(f32x2 x) {
    const f32x2 t = x * (f32x2){-1.4426950408889634f, -1.4426950408889634f}; f32x2 e = {__builtin_amdgcn_exp2f(t.x), __builtin_amdgcn_exp2f(t.y)};
    e += (f32x2){1.0f, 1.0f}; return (f32x2){__builtin_amdgcn_rcpf(e.x), __builtin_amdgcn_rcpf(e.y)}; }
__device__ __forceinline__ u32x4 pack8(const f32x4 a, const f32x4 b) { u32x4 w; w.x = cvt_pk_bf16(a[0], a[1]); w.y = cvt_pk_bf16(a[2], a[3]); w.z = cvt_pk_bf16(b[0], b[1]); w.w = cvt_pk_bf16(b[2], b[3]); return w; }

struct EpiSwiglu {
    static constexpr bool PERM = true, AFTER_DRAIN = false, MID = false;
    bf16_t* O; int ldc;
    __device__ __forceinline__ void operator()(const f32x4 (&acc)[2][2][4][2], const Unit& u, int wr, int wc, int fr, int fq) const {
        const int row0 = u.pm * BM + wr * 64 + fr, col0 = u.pn * HALF + wc * 32 + 8 * fq;
#pragma unroll
        for (int ai = 0; ai < 2; ++ai)
#pragma unroll
            for (int m = 0; m < 4; ++m) { bf16_t* rowp = O + (size_t)(row0 + ai * HALF + m * 16) * ldc + col0;
                f32x4 v[2];
#pragma unroll
                for (int n = 0; n < 2; ++n) { const f32x4 g = acc[ai][0][m][n], up = acc[ai][1][m][n];
#pragma unroll
                    for (int i = 0; i < 4; i += 2) { const f32x2 g2 = {g[i], g[i + 1]}, o2 = g2 * fast_sigmoid2(g2) * (f32x2){up[i], up[i + 1]}; v[n][i] = o2.x; v[n][i + 1] = o2.y; } }
                *(u32x4*)rowp = pack8(v[0], v[1]); }
    }
};

struct EpiPlainBf16 {
    static constexpr bool PERM = true, AFTER_DRAIN = false, MID = false;
    bf16_t* O; int ldc;
    __device__ __forceinline__ void operator()(const f32x4 (&acc)[2][2][4][2], const Unit& u, int wr, int wc, int fr, int fq) const {
        const int row0 = u.pm * BM + wr * 64 + fr, col0 = u.pn * BM + wc * 32 + 8 * fq;
#pragma unroll
        for (int ai = 0; ai < 2; ++ai)
#pragma unroll
            for (int m = 0; m < 4; ++m) { bf16_t* rowp = O + (size_t)(row0 + ai * HALF + m * 16) * ldc + col0;
#pragma unroll
                for (int bj = 0; bj < 2; ++bj) *(u32x4*)(rowp + bj * HALF) = pack8(acc[ai][bj][m][0], acc[ai][bj][m][1]); }
    }
};

struct EpiResid16 {
    static constexpr bool PERM = true, AFTER_DRAIN = false, MID = false;
    typedef _Float16 h16x4_t __attribute__((ext_vector_type(4)));
    _Float16* X; const float* gate; int gpitch; float coef;
    __device__ __forceinline__ void operator()(const f32x4 (&acc)[2][2][4][2], const Unit& u, int wr, int wc, int fr, int fq) const {
        const int row0 = u.pm * BM + wr * 64 + fr, col0 = u.pn * BM + wc * 32 + 8 * fq;
        const float* gp = gate + (size_t)((u.pm * BM) >> 12) * gpitch + col0;
        f32x4 cg[2][2];
#pragma unroll
        for (int bj = 0; bj < 2; ++bj)
#pragma unroll
            for (int n = 0; n < 2; ++n) cg[bj][n] = *(const f32x4*)(gp + bj * HALF + 4 * n) * coef;
        u32x4 xa[2][4][2];
#pragma unroll
        for (int ai = 0; ai < 2; ++ai)
#pragma unroll
            for (int m = 0; m < 4; ++m)
#pragma unroll
                for (int bj = 0; bj < 2; ++bj) xa[ai][m][bj] = *(const u32x4*)(X + (size_t)(row0 + ai * HALF + m * 16) * 2048 + col0 + bj * HALF);
#pragma unroll
        for (int ai = 0; ai < 2; ++ai) {
#pragma unroll
            for (int m = 0; m < 4; ++m)
#pragma unroll
                for (int bj = 0; bj < 2; ++bj) { const u32x4 w = xa[ai][m][bj];
                    const f32x4 x0 = __builtin_convertvector(__builtin_bit_cast(h16x4_t, (u32x2){w.x, w.y}), f32x4), x1 = __builtin_convertvector(__builtin_bit_cast(h16x4_t, (u32x2){w.z, w.w}), f32x4);
                    const f32x4 o0 = x0 + cg[bj][0] * acc[ai][bj][m][0], o1 = x1 + cg[bj][1] * acc[ai][bj][m][1];
                    const u32x2 p0 = __builtin_bit_cast(u32x2, __builtin_convertvector(o0, h16x4_t)), p1 = __builtin_bit_cast(u32x2, __builtin_convertvector(o1, h16x4_t));
                    *(u32x4*)(X + (size_t)(row0 + ai * HALF + m * 16) * 2048 + col0 + bj * HALF) = (u32x4){p0.x, p0.y, p1.x, p1.y}; }
        }
    }
};

template <int NF> __device__ __forceinline__ void rope_store(const f32x4 (&acc)[2][2][4][2], int ai, int m, const float* cosT, const float* sinT, size_t row, int d0, bf16_t* o1p, bf16_t* o2p) {
    const f32x4 c0 = *(const f32x4*)(cosT + row * NF + d0), c1 = *(const f32x4*)(cosT + row * NF + d0 + 4);
    const f32x4 s0 = *(const f32x4*)(sinT + row * NF + d0), s1 = *(const f32x4*)(sinT + row * NF + d0 + 4);
    const f32x4 a0 = acc[ai][0][m][0], a1 = acc[ai][0][m][1], b0 = acc[ai][1][m][0], b1 = acc[ai][1][m][1];
    const f32x4 r0 = a0 * c0 - b0 * s0, r1 = a1 * c1 - b1 * s1, q0 = b0 * c0 + a0 * s0, q1 = b1 * c1 + a1 * s1;
    *(u32x4*)o1p = pack8(r0, r1); *(u32x4*)o2p = pack8(q0, q1);
}

struct EpiWin {
    static constexpr bool PERM = true, AFTER_DRAIN = false, MID = false;
    bf16_t *QA, *KA, *VA, *KR; unsigned char* GATES; bf16_t *CQN, *CKVN; float *SSQ, *SSKV; const float *gq, *gkv, *cosA, *sinA, *cosR, *sinR, *bgate;
    __device__ __forceinline__ void operator()(const f32x4 (&acc)[2][2][4][2], const Unit& u, int wr, int wc, int fr, int fq) const {
        const int row0 = u.pm * BM + wr * 64 + fr, pn = u.pn;
        if (pn <= 4) {
            const int hsel = wc >> 1, d0 = 32 * (wc & 1) + 8 * fq;
            bf16_t* base; int ld, head;
            if (pn < 4) { base = QA; ld = 2048; head = 2 * pn + hsel; } else { base = KA; ld = 256; head = hsel; }
#pragma unroll
            for (int ai = 0; ai < 2; ++ai)
#pragma unroll
                for (int m = 0; m < 4; ++m) { const size_t row = (size_t)(row0 + ai * HALF + m * 16); bf16_t* o1 = base + row * ld + head * 128 + d0;
                    rope_store<64>(acc, ai, m, cosA, sinA, row, d0, o1, o1 + 64); }
        } else if (pn == 5) {
            const int col0 = wc * 32 + 8 * fq;
#pragma unroll
            for (int ai = 0; ai < 2; ++ai)
#pragma unroll
                for (int m = 0; m < 4; ++m) { bf16_t* rowp = VA + (size_t)(row0 + ai * HALF + m * 16) * 256 + col0;
#pragma unroll
                    for (int bj = 0; bj < 2; ++bj) *(u32x4*)(rowp + bj * HALF) = pack8(acc[ai][bj][m][0], acc[ai][bj][m][1]); }
        } else if (pn <= 9) {
            bf16_t* base = pn <= 7 ? CQN : CKVN; float* ssp = pn <= 7 ? SSQ : SSKV; const float* gp = (pn <= 7 ? gq : gkv); const int col0 = ((pn - 6) & 1) * 256 + wc * 32 + 8 * fq;
            f32x4 gv[2][2];
#pragma unroll
            for (int bj = 0; bj < 2; ++bj)
#pragma unroll
                for (int n = 0; n < 2; ++n) gv[bj][n] = *(const f32x4*)(gp + col0 + bj * HALF + 4 * n);
#pragma unroll
            for (int ai = 0; ai < 2; ++ai)
#pragma unroll
                for (int m = 0; m < 4; ++m) { const size_t row = (size_t)(row0 + ai * HALF + m * 16); bf16_t* rowp = base + row * 512 + col0; float ssq = 0.f;
#pragma unroll
                    for (int bj = 0; bj < 2; ++bj) {
#pragma unroll
                        for (int n = 0; n < 2; ++n) { const f32x4 t = acc[ai][bj][m][n]; ssq += (t[0] * t[0] + t[1] * t[1]) + (t[2] * t[2] + t[3] * t[3]); }
                        *(u32x4*)(rowp + bj * HALF) = pack8(acc[ai][bj][m][0] * gv[bj][0], acc[ai][bj][m][1] * gv[bj][1]); }
                    { auto r = __builtin_amdgcn_permlane16_swap(__float_as_uint(ssq), __float_as_uint(ssq), false, false); ssq = __uint_as_float(r[0]) + __uint_as_float(r[1]); }
                    { auto r = __builtin_amdgcn_permlane32_swap(__float_as_uint(ssq), __float_as_uint(ssq), false, false); ssq = __uint_as_float(r[0]) + __uint_as_float(r[1]); }
                    if (fq == 0) unsafeAtomicAdd(ssp + row, ssq); }
        } else if (pn == 10) {
            if (wc == 0) { const int d0 = 8 * fq;
#pragma unroll
                for (int ai = 0; ai < 2; ++ai)
#pragma unroll
                    for (int m = 0; m < 4; ++m) { const size_t row = (size_t)(row0 + ai * HALF + m * 16); bf16_t* o1 = KR + row * 64 + d0;
                        rope_store<32>(acc, ai, m, cosR, sinR, row, d0, o1, o1 + 32); } }
        } else {
            const int col0 = (pn - 11) * 256 + wc * 32 + 8 * fq;
            f32x4 bv[2][2];
#pragma unroll
            for (int bj = 0; bj < 2; ++bj)
#pragma unroll
                for (int n = 0; n < 2; ++n) bv[bj][n] = *(const f32x4*)(bgate + col0 + bj * HALF + 4 * n);
#pragma unroll
            for (int ai = 0; ai < 2; ++ai)
#pragma unroll
                for (int m = 0; m < 4; ++m) { unsigned char* rowp = GATES + (size_t)(row0 + ai * HALF + m * 16) * 4096 + col0;
#pragma unroll
                    for (int bj = 0; bj < 2; ++bj) { u32x2 w;
#pragma unroll
                        for (int n = 0; n < 2; ++n) { const f32x4 t = acc[ai][bj][m][n] + bv[bj][n]; unsigned q[4];
#pragma unroll
                            for (int i = 0; i < 4; i += 2) { const f32x2 s2 = __builtin_elementwise_fma(fast_sigmoid2((f32x2){t[i], t[i + 1]}), (f32x2){255.0f, 255.0f}, (f32x2){8388608.0f, 8388608.0f});
                                q[i] = __float_as_uint(s2.x); q[i + 1] = __float_as_uint(s2.y); }
                            w[n] = __builtin_amdgcn_perm(q[1], q[0], 0x0c0c0400u) | __builtin_amdgcn_perm(q[3], q[2], 0x04000c0cu); }
                        *(u32x2*)(rowp + bj * HALF) = w; } }
        }
    }
};

__device__ __forceinline__ void row_rstd512(const float* ss, int row0, float (&rs)[2][4]) {
#pragma unroll
    for (int ai = 0; ai < 2; ++ai)
#pragma unroll
        for (int m = 0; m < 4; ++m) rs[ai][m] = 1.0f / sqrtf(ss[row0 + ai * HALF + m * 16] * (1.0f / 512.0f) + 1e-6f);
}
struct EpiUq {
    static constexpr bool PERM = true, AFTER_DRAIN = false, MID = false;
    bf16_t *QBN, *QBR; const float *cosR, *sinR, *ss;
    __device__ __forceinline__ void operator()(f32x4 (&acc)[2][2][4][2], const Unit& u, int wr, int wc, int fr, int fq) const {
        const int row0 = u.pm * BM + wr * 64 + fr, pn = u.pn;
        float rs[2][4]; row_rstd512(ss, row0, rs);
#pragma unroll
        for (int ai = 0; ai < 2; ++ai)
#pragma unroll
            for (int m = 0; m < 4; ++m)
#pragma unroll
                for (int bj = 0; bj < 2; ++bj)
#pragma unroll
                    for (int n = 0; n < 2; ++n) acc[ai][bj][m][n] = acc[ai][bj][m][n] * rs[ai][m];
        if (pn < 4) {
            const int col0 = pn * BM + wc * 32 + 8 * fq;
#pragma unroll
            for (int ai = 0; ai < 2; ++ai)
#pragma unroll
                for (int m = 0; m < 4; ++m) { bf16_t* rowp = QBN + (size_t)(row0 + ai * HALF + m * 16) * 2048 + col0;
#pragma unroll
                    for (int bj = 0; bj < 2; ++bj) *(u32x4*)(rowp + bj * HALF) = pack8(acc[ai][bj][m][0], acc[ai][bj][m][1]); }
        } else {
            const int head = 4 * (pn - 4) + wc, d0 = 8 * fq;
#pragma unroll
            for (int ai = 0; ai < 2; ++ai)
#pragma unroll
                for (int m = 0; m < 4; ++m) { const size_t row = (size_t)(row0 + ai * HALF + m * 16); bf16_t* o1 = QBR + row * 512 + head * 64 + d0;
                    rope_store<32>(acc, ai, m, cosR, sinR, row, d0, o1, o1 + 32); }
        }
    }
};
struct EpiScaledBf16 {
    static constexpr bool PERM = true, AFTER_DRAIN = false, MID = false;
    bf16_t* O; int ldc; const float* ss;
    __device__ __forceinline__ void operator()(const f32x4 (&acc)[2][2][4][2], const Unit& u, int wr, int wc, int fr, int fq) const {
        const int row0 = u.pm * BM + wr * 64 + fr, col0 = u.pn * BM + wc * 32 + 8 * fq;
        float rs[2][4]; row_rstd512(ss, row0, rs);
#pragma unroll
        for (int ai = 0; ai < 2; ++ai)
#pragma unroll
            for (int m = 0; m < 4; ++m) { bf16_t* rowp = O + (size_t)(row0 + ai * HALF + m * 16) * ldc + col0;
#pragma unroll
                for (int bj = 0; bj < 2; ++bj) *(u32x4*)(rowp + bj * HALF) = pack8(acc[ai][bj][m][0] * rs[ai][m], acc[ai][bj][m][1] * rs[ai][m]); }
    }
};

struct EpiGateMerge {
    static constexpr bool PERM = true, AFTER_DRAIN = false, MID = MERGE_MID;
    const unsigned char* G; bf16_t* O;
    static __device__ __forceinline__ f32x4 ub4(unsigned w) { return (f32x4){(float)(w & 0xffu), (float)((w >> 8) & 0xffu), (float)((w >> 16) & 0xffu), (float)(w >> 24)}; }
    __device__ __forceinline__ void mid(f32x4 (&acc)[2][2][4][2], const Unit& u, int wr, int wc, int fr_, int fq_) const {
        int fr = fr_, fq = fq_; asm volatile("" : "+v"(fr), "+v"(fq));
        const int row0 = u.pm * BM + wr * 64 + fr, col0 = u.pn * BM + wc * 32 + 8 * fq;
#pragma unroll
        for (int ai = 0; ai < 2; ++ai) {
            u32x2 ga[4][2], gb[4][2];
#pragma unroll
            for (int m = 0; m < 4; ++m) { const unsigned char* gp = G + (size_t)(row0 + ai * HALF + m * 16) * 4096 + col0;
#pragma unroll
                for (int bj = 0; bj < 2; ++bj) { ga[m][bj] = *(const u32x2*)(gp + bj * HALF); gb[m][bj] = *(const u32x2*)(gp + 2048 + bj * HALF); } }
#pragma unroll
            for (int m = 0; m < 4; ++m)
#pragma unroll
                for (int bj = 0; bj < 2; ++bj) { const u32x2 A = ga[m][bj], Bv = gb[m][bj];
                    const f32x4 a0 = ub4(A.x), a1 = ub4(A.y);
                    f32x4 b0 = ub4(Bv.x), b1 = ub4(Bv.y);
#pragma unroll
                    for (int i = 0; i < 4; ++i) { b0[i] = fmaxf(b0[i], 1e-30f); b1[i] = fmaxf(b1[i], 1e-30f); }
#pragma unroll
                    for (int i = 0; i < 4; ++i) { acc[ai][bj][m][0][i] *= a0[i] * __builtin_amdgcn_rcpf(b0[i]); acc[ai][bj][m][1][i] *= a1[i] * __builtin_amdgcn_rcpf(b1[i]); } }
            asm volatile("" ::: "memory");
        }
    }
    __device__ __forceinline__ void operator()(const f32x4 (&acc)[2][2][4][2], const Unit& u, int wr, int wc, int fr, int fq) const {
        const int row0 = u.pm * BM + wr * 64 + fr, col0 = u.pn * BM + wc * 32 + 8 * fq;
#pragma unroll
        for (int ai = 0; ai < 2; ++ai)
#pragma unroll
            for (int m = 0; m < 4; ++m) { const size_t row = (size_t)(row0 + ai * HALF + m * 16);
#pragma unroll
                for (int bj = 0; bj < 2; ++bj) { const int col = col0 + bj * HALF; const u32x2 gb = *(const u32x2*)(G + row * 4096 + 2048 + col);
                    f32x4 g0 = ub4(gb.x), g1 = ub4(gb.y);
#pragma unroll
                    for (int i = 0; i < 4; ++i) { g0[i] = fmaxf(g0[i], 1e-30f) * (1.0f / 255.0f); g1[i] = fmaxf(g1[i], 1e-30f) * (1.0f / 255.0f); }
                    const f32x4 v0 = acc[ai][bj][m][0] * g0, v1 = acc[ai][bj][m][1] * g1;
                    *(u32x4*)(O + row * 2048 + col) = pack8(v0, v1); } }
    }
};
template <class Epi, class Sched, bool ALIGN_EPI = false, bool SP2 = false>
__device__ __forceinline__ void gemm_phase(PG8_LAS unsigned char* lds, const Gemm g, const Sched& S, const Epi& E, const int wave_s) {
    int tid_ = wave_s * 64 + lane_id_fresh(); asm volatile("" : "+v"(tid_));
    const int tid = tid_, wid = __builtin_amdgcn_readfirstlane(tid >> 6), lane = tid & 63, wr = wid >> 2, wc = wid & 3, fr = lane & 15, fq = lane >> 4;
    const int K = g.K, nt = K / BK;
    unsigned voffA[2], voffB[2];
#pragma unroll
    for (int i = 0; i < 2; ++i) { int R, C; stage_rc(tid * 16 + i * 8192, R, C); const int Rb = Epi::PERM ? ((R & ~31) + perm32(R & 31)) : R;
        voffA[i] = (unsigned)(R * K + C) * 2u; voffB[i] = (unsigned)(Rb * K + C) * 2u; }
    const size_t kstep = (size_t)(BK * 2);
    const size_t hstep = (size_t)HALF * K * 2;
    const size_t tstep = 2 * hstep;
    const unsigned ldsw = (unsigned)wid * 1024u;
    const int aoff = lds_byte(wr * 64 + fr, fq * 8), boff = lds_byte(wc * 32 + fr, fq * 8);
#define PG8_SA(b, h) (((b) * 2 + (h)) * HTB)
#define PG8_SB(b, h) ((4 + (b) * 2 + (h)) * HTB)
#define PG8_STAGE(bufoff, gbase, voff) do { _Pragma("unroll") for (int _i = 0; _i < 2; ++_i) \
        __builtin_amdgcn_global_load_lds((const unsigned*)((const char*)(gbase) + (voff)[_i]), (PG8_LAS unsigned*)(lds + (bufoff) + ldsw + _i * 8192), 16, 0, 0); } while (0)
#define PG8_LDA(dst, b, h) do { _Pragma("unroll") for (int m = 0; m < 4; ++m) _Pragma("unroll") for (int k = 0; k < 2; ++k) dst[m][k] = *(const PG8_LAS bf16x8*)(lds + PG8_SA(b, h) + aoff + m * 2048 + k * 1024); } while (0)
#define PG8_LDB(dst, b, h) do { _Pragma("unroll") for (int n = 0; n < 2; ++n) _Pragma("unroll") for (int k = 0; k < 2; ++k) dst[n][k] = *(const PG8_LAS bf16x8*)(lds + PG8_SB(b, h) + boff + n * 2048 + k * 1024); } while (0)
#define PG8_MMA(ai, bj, At, Bt) do { __builtin_amdgcn_s_setprio(1); _Pragma("unroll") for (int m = 0; m < 4; ++m) _Pragma("unroll") for (int n = 0; n < 2; ++n) _Pragma("unroll") for (int k = 0; k < 2; ++k) \
        acc[ai][bj][m][n] = __builtin_amdgcn_mfma_f32_16x16x32_bf16(Bt[n][k], At[m][k], acc[ai][bj][m][n], 0, 0, 0); __builtin_amdgcn_s_setprio(0); } while (0)
#define PG8_WAIT_V(n) asm volatile("s_waitcnt vmcnt(" #n ")" ::: "memory")
#define PG8_WAIT_L(n) asm volatile("s_waitcnt lgkmcnt(" #n ")" ::: "memory")
#define PG8_BAR __builtin_amdgcn_s_barrier()
#define PG8_SCHED __builtin_amdgcn_sched_barrier(0)
    Unit cur, nxt; int ui = 0;
    if (!S.next(0, cur)) return;
    f32x4 acc[2][2][4][2];
#pragma unroll
    for (int a = 0; a < 2; ++a)
#pragma unroll
        for (int b = 0; b < 2; ++b)
#pragma unroll
            for (int m = 0; m < 4; ++m)
#pragma unroll
                for (int n = 0; n < 2; ++n) acc[a][b][m][n] = (f32x4){0.f, 0.f, 0.f, 0.f};
    bf16x8 At[4][2], B0[2][2], B1[2][2];
    const char* cA = (const char*)g.A + (size_t)cur.pm * tstep; const char* cB = (const char*)g.Bt + (size_t)cur.pn * tstep;
    S.a_ready(cur);
    if constexpr (SP2) {
        PG8_STAGE(PG8_SB(0, 0), cB, voffB); PG8_STAGE(PG8_SB(0, 1), cB + hstep, voffB); PG8_STAGE(PG8_SA(0, 0), cA, voffA); PG8_STAGE(PG8_SA(0, 1), cA + hstep, voffA);
        if (wr == 1) PG8_BAR;
        PG8_WAIT_V(2); PG8_BAR;
        PG8_STAGE(PG8_SB(1, 0), cB + kstep, voffB); PG8_STAGE(PG8_SA(1, 0), cA + kstep, voffA); PG8_STAGE(PG8_SB(1, 1), cB + hstep + kstep, voffB);
        PG8_WAIT_V(6); PG8_BAR;
    } else {
        PG8_STAGE(PG8_SB(0, 0), cB, voffB); PG8_STAGE(PG8_SA(0, 0), cA, voffA); PG8_STAGE(PG8_SB(0, 1), cB + hstep, voffB); PG8_STAGE(PG8_SA(0, 1), cA + hstep, voffA);
        if (wr == 1) PG8_BAR;
        PG8_WAIT_V(4); PG8_BAR;
        PG8_STAGE(PG8_SB(1, 0), cB + kstep, voffB); PG8_STAGE(PG8_SA(1, 0), cA + kstep, voffA); PG8_STAGE(PG8_SB(1, 1), cB + hstep + kstep, voffB);
        PG8_WAIT_V(6); PG8_BAR;
    }
    for (;;) {
        const bool has_next = S.next(ui + 1, nxt);
        const char* nA = has_next ? (const char*)g.A + (size_t)nxt.pm * tstep : cA; const char* nB = has_next ? (const char*)g.Bt + (size_t)nxt.pn * tstep : cB;
        for (int t = 0; t < nt; t += 2) {
            const bool last = (t == nt - 2);
            const char* a1 = cA + (size_t)(t + 1) * kstep;
            const char* a2 = last ? nA : cA + (size_t)(t + 2) * kstep; const char* b2 = last ? nB : cB + (size_t)(t + 2) * kstep;
            const char* a3 = a2 + kstep; const char* b3 = b2 + kstep;
            if (last && has_next) S.a_ready(nxt);
            if constexpr (SP2) {
            PG8_LDB(B0, 0, 0); PG8_LDB(B1, 0, 1); PG8_SCHED; PG8_LDA(At, 0, 0); PG8_STAGE(PG8_SA(1, 1), a1 + hstep, voffA);
            PG8_WAIT_V(8); PG8_WAIT_L(0); PG8_BAR; PG8_MMA(0, 0, At, B0); PG8_MMA(0, 1, At, B1); PG8_BAR; PG8_SCHED;
            PG8_LDA(At, 0, 1); PG8_STAGE(PG8_SB(0, 0), b2, voffB); PG8_STAGE(PG8_SB(0, 1), b2 + hstep, voffB); PG8_STAGE(PG8_SA(0, 0), a2, voffA);
            PG8_WAIT_V(8); PG8_WAIT_L(0); PG8_BAR; PG8_MMA(1, 0, At, B0); PG8_MMA(1, 1, At, B1); PG8_BAR; PG8_SCHED;
            PG8_LDB(B0, 1, 0); PG8_LDB(B1, 1, 1); PG8_SCHED; PG8_LDA(At, 1, 0); PG8_STAGE(PG8_SA(0, 1), a2 + hstep, voffA);
            PG8_WAIT_V(8); PG8_WAIT_L(0); PG8_BAR; PG8_MMA(0, 0, At, B0); PG8_MMA(0, 1, At, B1); PG8_BAR; PG8_SCHED;
            PG8_LDA(At, 1, 1); PG8_STAGE(PG8_SB(1, 0), b3, voffB); PG8_STAGE(PG8_SB(1, 1), b3 + hstep, voffB); PG8_STAGE(PG8_SA(1, 0), a3, voffA);
            PG8_WAIT_V(8); PG8_WAIT_L(0); PG8_BAR; PG8_MMA(1, 0, At, B0); PG8_MMA(1, 1, At, B1); PG8_BAR; PG8_SCHED;
            } else {
            PG8_LDB(B0, 0, 0); PG8_SCHED; PG8_LDA(At, 0, 0); PG8_STAGE(PG8_SA(1, 1), a1 + hstep, voffA);
            PG8_WAIT_L(8); PG8_BAR; PG8_WAIT_L(0); PG8_MMA(0, 0, At, B0); PG8_BAR; PG8_SCHED;
            PG8_LDB(B1, 0, 1); PG8_STAGE(PG8_SB(0, 0), b2, voffB);
            PG8_BAR; PG8_WAIT_L(0); PG8_MMA(0, 1, At, B1); PG8_BAR;
            PG8_LDA(At, 0, 1); PG8_STAGE(PG8_SA(0, 0), a2, voffA);
            PG8_BAR; PG8_WAIT_L(0); PG8_MMA(1, 0, At, B0); PG8_BAR; PG8_SCHED;
            PG8_STAGE(PG8_SB(0, 1), b2 + hstep, voffB);
            PG8_WAIT_V(6); PG8_BAR; PG8_MMA(1, 1, At, B1); PG8_BAR;
            PG8_LDB(B0, 1, 0); PG8_SCHED; PG8_LDA(At, 1, 0); PG8_STAGE(PG8_SA(0, 1), a2 + hstep, voffA);
            PG8_WAIT_L(8); PG8_BAR; PG8_WAIT_L(0); PG8_MMA(0, 0, At, B0); PG8_BAR; PG8_SCHED;
            PG8_LDB(B1, 1, 1); PG8_STAGE(PG8_SB(1, 0), b3, voffB);
            PG8_BAR; PG8_WAIT_L(0); PG8_MMA(0, 1, At, B1); PG8_BAR;
            PG8_LDA(At, 1, 1); PG8_STAGE(PG8_SA(1, 0), a3, voffA);
            PG8_BAR; PG8_WAIT_L(0); PG8_MMA(1, 0, At, B0); PG8_BAR; PG8_SCHED;
            PG8_STAGE(PG8_SB(1, 1), b3 + hstep, voffB);
            PG8_WAIT_V(6); PG8_BAR; PG8_MMA(1, 1, At, B1); PG8_BAR;
            }
            if constexpr (Epi::MID) { if (t == nt / 2 - 2) { PG8_SCHED; E.mid(acc, cur, wr, wc, fr, fq); PG8_SCHED; } }
        }
        if constexpr (ALIGN_EPI) { if (wr == 0) PG8_BAR; }
        if constexpr (!Epi::AFTER_DRAIN) { E(acc, cur, wr, wc, fr, fq); S.done(cur); }
        if (!has_next) break;
#pragma unroll
        for (int a = 0; a < 2; ++a)
#pragma unroll
            for (int b = 0; b < 2; ++b)
#pragma unroll
                for (int m = 0; m < 4; ++m)
#pragma unroll
                    for (int n = 0; n < 2; ++n) acc[a][b][m][n] = (f32x4){0.f, 0.f, 0.f, 0.f};
        cur = nxt; cA = nA; cB = nB; ++ui;
        if constexpr (ALIGN_EPI) { if (wr == 1) PG8_BAR; }
    }
    PG8_WAIT_V(0);
    if constexpr (!ALIGN_EPI) { if (wr == 0) PG8_BAR; }
    PG8_BAR;
    if constexpr (Epi::AFTER_DRAIN) { E.fused(acc, cur, wr, wc, fr, fq, lds, wid, lane); S.done(cur); }
#undef PG8_SA
#undef PG8_SB
#undef PG8_STAGE
#undef PG8_LDA
#undef PG8_LDB
#undef PG8_MMA
#undef PG8_WAIT_V
#undef PG8_WAIT_L
#undef PG8_BAR
#undef PG8_SCHED
}
}
namespace att {
typedef unsigned short bf16;
using bf16x8 = __attribute__((ext_vector_type(8))) short;
using s16x4  = __attribute__((ext_vector_type(4))) short;
using f32x16 = __attribute__((ext_vector_type(16))) float;
using u32x4  = __attribute__((ext_vector_type(4))) unsigned;
using f32x2  = __attribute__((ext_vector_type(2))) float;
constexpr int NW = 8, QBLK = 32, KVBLK = 64;
constexpr int SHM_V = KVBLK * 128 * 2, SHM_K = KVBLK * 128 * 2, SHM_KR = KVBLK * 64 * 2;
constexpr int O3_V = 0, O3_K = 3 * SHM_V, O3_KR = O3_K + 3 * SHM_K, O3_WS = O3_KR + 3 * SHM_KR, O3_QR = O3_WS + NW * 64 * 4, ATT3_LDS = O3_QR + NW * 4096;
#define KSWZ(row, colB) ((row) * 256 + ((colB) ^ (((row) & 15) << 4)))
#define KRSWZ(row, colB) ((row) * 128 + ((colB) ^ ((((row) >> 1) & 7) << 4)))
#define SBAR() __builtin_amdgcn_sched_barrier(0)
__device__ __forceinline__ int crow(int r, int hi) { return (r & 3) + 8 * (r >> 2) + 4 * hi; }
typedef __bf16 bf16x2_t __attribute__((ext_vector_type(2)));
__device__ __forceinline__ unsigned cvtpk(float lo, float hi) { const float __attribute__((ext_vector_type(2))) v = {lo, hi}; return __builtin_bit_cast(unsigned, __builtin_convertvector(v, bf16x2_t)); }

template <bool MASK> __device__ __forceinline__ void partialSM(f32x16& p0, f32x16& p1, float& m_reg, float& mn, float& alpha, const float C, const float THRR, int qi, int kb, int hi) {
  if (MASK) {
    int t = qi - 128 - kb - 4 * hi; asm volatile("" : "+v"(t));
#pragma unroll
    for (int r = 0; r < 16; ++r) { const int cr = (r & 3) + 8 * (r >> 2);
      p0[r] = ((unsigned)(cr - t) <= 256u) ? p0[r] : -__builtin_inff();
      p1[r] = ((unsigned)(cr + 32 - t) <= 256u) ? p1[r] : -__builtin_inff(); }
  }
  float pmax = p0[0];
#pragma unroll
  for (int r = 1; r < 16; ++r) pmax = fmaxf(pmax, p0[r]);
#pragma unroll
  for (int r = 0; r < 16; ++r) pmax = fmaxf(pmax, p1[r]);
  { auto rr = __builtin_amdgcn_permlane32_swap(__float_as_uint(pmax), __float_as_uint(pmax), false, false);
    pmax = fmaxf(__uint_as_float(rr[0]), __uint_as_float(rr[1])); }
  if (__builtin_expect(__all(pmax - m_reg <= THRR), 1)) { mn = m_reg; alpha = 1.f; }
  else { mn = fmaxf(m_reg, pmax); alpha = __builtin_amdgcn_exp2f((m_reg - mn) * C); m_reg = mn; }
  const float mnC = -mn * C; const f32x2 C2 = {C, C}, mnC2 = {mnC, mnC};
#pragma unroll
  for (int r = 0; r < 16; r += 2) { const f32x2 t = __builtin_elementwise_fma((f32x2){p0[r], p0[r + 1]}, C2, mnC2); p0[r] = t.x; p0[r + 1] = t.y; }
#pragma unroll
  for (int r = 0; r < 16; r += 2) { const f32x2 t = __builtin_elementwise_fma((f32x2){p1[r], p1[r + 1]}, C2, mnC2); p1[r] = t.x; p1[r + 1] = t.y; }
#pragma unroll
  for (int r = 0; r < 16; ++r) p0[r] = __builtin_amdgcn_exp2f(p0[r]);
}
__device__ __forceinline__ void finishSM(f32x16& p0, f32x16& p1, float alpha, float& l_reg, bf16x8& pa0, bf16x8& pa1, bf16x8& pa2, bf16x8& pa3) {
#pragma unroll
  for (int r = 0; r < 16; ++r) p1[r] = __builtin_amdgcn_exp2f(p1[r]);
  f32x2 ps2 = {p0[0], p0[1]};
#pragma unroll
  for (int r = 2; r < 16; r += 2) ps2 += (f32x2){p0[r], p0[r + 1]};
#pragma unroll
  for (int r = 0; r < 16; r += 2) ps2 += (f32x2){p1[r], p1[r + 1]};
  float ps = ps2.x + ps2.y;
  { auto rr = __builtin_amdgcn_permlane32_swap(__float_as_uint(ps), __float_as_uint(ps), false, false);
    ps = __uint_as_float(rr[0]) + __uint_as_float(rr[1]); }
  l_reg = l_reg * alpha + ps;
#define PK4(P, BASE, OUT) do { unsigned a0 = cvtpk(P[BASE + 0], P[BASE + 1]), a1 = cvtpk(P[BASE + 2], P[BASE + 3]);   \
    unsigned b0 = cvtpk(P[BASE + 4], P[BASE + 5]), b1 = cvtpk(P[BASE + 6], P[BASE + 7]);                              \
    auto r0 = __builtin_amdgcn_permlane32_swap(a0, b0, false, false); auto r1 = __builtin_amdgcn_permlane32_swap(a1, b1, false, false); \
    u32x4 w = {r0[0], r1[0], r0[1], r1[1]}; OUT = *reinterpret_cast<bf16x8*>(&w); } while (0)
  PK4(p0, 0, pa0); PK4(p0, 8, pa1); PK4(p1, 0, pa2); PK4(p1, 8, pa3);
#undef PK4
}
template <int NR> __device__ __forceinline__ void qkt(f32x16& p0, f32x16& p1, const char* Ks, const char* KRs, const bf16x8* qr, const char* qrl, int r32, int hi) {
  p0 = f32x16{}; p1 = f32x16{};
#pragma unroll
  for (int d0 = 0; d0 < 8; ++d0) { const int cb = (d0 * 16 + hi * 8) * 2;
    const bf16x8 b0 = *reinterpret_cast<const bf16x8*>(Ks + KSWZ(r32, cb));
    const bf16x8 b1 = *reinterpret_cast<const bf16x8*>(Ks + KSWZ(32 + r32, cb));
    p0 = __builtin_amdgcn_mfma_f32_32x32x16_bf16(b0, qr[d0], p0, 0, 0, 0);
    p1 = __builtin_amdgcn_mfma_f32_32x32x16_bf16(b1, qr[d0], p1, 0, 0, 0); }
#pragma unroll
  for (int d0 = 0; d0 < NR; ++d0) { const int cb = (d0 * 16 + hi * 8) * 2;
    const bf16x8 b0 = *reinterpret_cast<const bf16x8*>(KRs + KRSWZ(r32, cb));
    const bf16x8 b1 = *reinterpret_cast<const bf16x8*>(KRs + KRSWZ(32 + r32, cb));
    const bf16x8 qf = *reinterpret_cast<const bf16x8*>(qrl + d0 * 1024);
    p0 = __builtin_amdgcn_mfma_f32_32x32x16_bf16(b0, qf, p0, 0, 0, 0);
    p1 = __builtin_amdgcn_mfma_f32_32x32x16_bf16(b1, qf, p1, 0, 0, 0); }
}
__device__ __forceinline__ int v_st(int k, int c) { const int kk = (k & ~0xC) | ((k & 4) << 1) | ((k & 8) >> 1); return ((kk >> 3) * 4 + (c >> 5)) * 512 + ((kk & 7) * 32 + (c & 31)) * 2; }
__device__ __forceinline__ int v_rd_base(int lane) { return ((lane & 3) << 3) | (((lane >> 2) & 3) << 6) | (((lane >> 4) & 1) << 5) | (((lane >> 5) & 1) << 8); }
constexpr int v_rd_off(int d0, int ks, int half) { return d0 * 512 + ks * 4096 + half * 2048; }
template <int OFF> __device__ __forceinline__ s16x4 tr_read(int vb) { s16x4 r; asm volatile("ds_read_b64_tr_b16 %0, %1 offset:%2" : "=&v"(r) : "v"(vb), "i"(OFF) : "memory"); return r; }
template <int D0> __device__ __forceinline__ void pv_one(f32x16& od, int vb, bf16x8 pa0, bf16x8 pa1, bf16x8 pa2, bf16x8 pa3) {
  const s16x4 l0 = tr_read<v_rd_off(D0, 0, 0)>(vb), h0 = tr_read<v_rd_off(D0, 0, 1)>(vb), l1 = tr_read<v_rd_off(D0, 1, 0)>(vb), h1 = tr_read<v_rd_off(D0, 1, 1)>(vb);
  const s16x4 l2 = tr_read<v_rd_off(D0, 2, 0)>(vb), h2 = tr_read<v_rd_off(D0, 2, 1)>(vb), l3 = tr_read<v_rd_off(D0, 3, 0)>(vb), h3 = tr_read<v_rd_off(D0, 3, 1)>(vb);
  asm volatile("s_waitcnt lgkmcnt(0)" ::: "memory"); SBAR();
#define PK(L, H) (bf16x8){L[0], L[1], L[2], L[3], H[0], H[1], H[2], H[3]}
  od = __builtin_amdgcn_mfma_f32_32x32x16_bf16(pa0, PK(l0, h0), od, 0, 0, 0);
  od = __builtin_amdgcn_mfma_f32_32x32x16_bf16(pa1, PK(l1, h1), od, 0, 0, 0);
  od = __builtin_amdgcn_mfma_f32_32x32x16_bf16(pa2, PK(l2, h2), od, 0, 0, 0);
  od = __builtin_amdgcn_mfma_f32_32x32x16_bf16(pa3, PK(l3, h3), od, 0, 0, 0);
#undef PK
}
__device__ __forceinline__ void pv_d0(f32x16* o, int vb, bf16x8 pa0, bf16x8 pa1, bf16x8 pa2, bf16x8 pa3) {
  pv_one<0>(o[0], vb, pa0, pa1, pa2, pa3); pv_one<1>(o[1], vb, pa0, pa1, pa2, pa3); pv_one<2>(o[2], vb, pa0, pa1, pa2, pa3); pv_one<3>(o[3], vb, pa0, pa1, pa2, pa3);
}

__device__ __forceinline__ void glds16(const void* gsrc, unsigned lds_dst) {
  unsigned keep; asm volatile("s_mov_b32 %0, m0\n\ts_mov_b32 m0, %2\n\ts_nop 0\n\tglobal_load_lds_dwordx4 %1, off\n\ts_mov_b32 m0, %0" : "=&s"(keep) : "v"(gsrc), "s"(lds_dst) : "memory"); }
template <bool MLA, int LDQ, int LDQR, int LDK>
__device__ __forceinline__ void attn_body_dma(const bf16* Qb, const bf16* Qrb, const bf16* __restrict__ Kh, const bf16* __restrict__ Vh, const bf16* __restrict__ KRh,
                                              bf16* Ob, int NT, const float C, const float THRR, const float m0, const float l0, int q0, int kb0, char* lds, const int wave_s) {
  constexpr int NR = MLA ? 4 : 0;
  int tid_ = wave_s * 64 + lane_id_fresh(); asm volatile("" : "+v"(tid_));
  const int tid = tid_, wid = tid >> 6, lane = tid & 63, r32 = lane & 31, hi = lane >> 5;
  char* V_lds = lds + O3_V; char* K_lds = lds + O3_K; char* KR_lds = lds + O3_KR;
  float* wsf = (float*)(lds + O3_WS) + wid * 64; float* li_l = wsf; float* al_l = wsf + 32;
  float m_reg = m0, l_reg = l0; f32x16 o[4] = {}; bf16x8 qr[8];
  const bf16* Qw = Qb + (long)(wid * QBLK + r32) * LDQ + hi * 8;
#pragma unroll
  for (int d0 = 0; d0 < 8; ++d0) qr[d0] = *reinterpret_cast<const bf16x8*>(Qw + d0 * 16);
  const char* qrl = lds + O3_QR + wid * 4096 + lane * 16;
  if (MLA) { const bf16* Qrw = Qrb + (long)(wid * QBLK + r32) * LDQR + hi * 8;
#pragma unroll
    for (int d0 = 0; d0 < NR; ++d0) *(bf16x8*)(lds + O3_QR + wid * 4096 + lane * 16 + d0 * 1024) = *reinterpret_cast<const bf16x8*>(Qrw + d0 * 16); }
  const int qi = q0 + wid * QBLK + r32;
  const int vb0 = (int)(uintptr_t)V_lds + v_rd_base(lane);
  unsigned offK[2], offV[2], offKR;
#pragma unroll
  for (int i = 0; i < 2; ++i) { const int B = (2 * wid + i) * 1024 + 16 * lane;
    { const int row = B >> 8, pc = (B >> 4) & 15; offK[i] = (unsigned)(row * LDK * 2 + ((pc ^ (row & 15)) << 4)); }
    { const int s_ = B >> 9, o_ = B & 511, kk = (s_ >> 2) * 8 + (o_ >> 6), c = (s_ & 3) * 32 + ((o_ & 63) >> 1), k = (kk & ~0xC) | ((kk & 4) << 1) | ((kk & 8) >> 1);
      offV[i] = (unsigned)(k * LDK * 2 + c * 2); } }
  { const int B = wid * 1024 + 16 * lane, row = B >> 7, pc = (B >> 4) & 7; offKR = (unsigned)(row * 128 + ((pc ^ ((row >> 1) & 7)) << 4)); }
  const unsigned ldsb = (unsigned)__builtin_amdgcn_readfirstlane((int)(uintptr_t)lds);
  const unsigned ldsV = ldsb + O3_V + 2 * wave_s * 1024, ldsK = ldsb + O3_K + 2 * wave_s * 1024, ldsKR = ldsb + O3_KR + wave_s * 1024;
#define DMA_TILE(t, b) do { const size_t tb_ = (size_t)(t) * (KVBLK * LDK * 2); \
    glds16((const char*)Kh + tb_ + offK[0], ldsK + (b) * SHM_K); glds16((const char*)Kh + tb_ + offK[1], ldsK + (b) * SHM_K + 1024); \
    glds16((const char*)Vh + tb_ + offV[0], ldsV + (b) * SHM_V); glds16((const char*)Vh + tb_ + offV[1], ldsV + (b) * SHM_V + 1024); \
    if (MLA) glds16((const char*)KRh + (size_t)(t) * (KVBLK * 128) + offKR, ldsKR + (b) * SHM_KR); } while (0)
#define PUBLISH() asm volatile("s_waitcnt vmcnt(0)\n\ts_barrier" ::: "memory")
#define RESC3(a) do { if (__any((a) < 1.f)) { if (hi == 0) al_l[r32] = (a); asm volatile("s_waitcnt lgkmcnt(0)" ::: "memory"); \
    _Pragma("unroll") for (int d = 0; d < 4; ++d) _Pragma("unroll") for (int r = 0; r < 16; ++r) o[d][r] *= al_l[crow(r, hi)]; } } while (0)
  f32x16 pA0, pA1, pB0, pB1; float mnA, mnB, alA, alB; bf16x8 pa0, pa1, pa2, pa3;
  DMA_TILE(0, 0); DMA_TILE(1, 1); asm volatile("s_waitcnt lgkmcnt(0)" ::: "memory"); PUBLISH();
  qkt<NR>(pA0, pA1, K_lds, KR_lds, qr, qrl, r32, hi); partialSM<!MLA>(pA0, pA1, m_reg, mnA, alA, C, THRR, qi, kb0, hi);
  int bprev = 0, bcur = 1, bnext = 2;
#define ROT3() do { const int t_ = bprev; bprev = bcur; bcur = bnext; bnext = t_; } while (0)
  for (int j = 1; j + 1 < NT; j += 2) {
    DMA_TILE(j + 1, bnext);
    SBAR(); qkt<NR>(pB0, pB1, K_lds + bcur * SHM_K, KR_lds + bcur * SHM_KR, qr, qrl, r32, hi);
    finishSM(pA0, pA1, alA, l_reg, pa0, pa1, pa2, pa3); SBAR();
    pv_d0(o, vb0 + bprev * SHM_V, pa0, pa1, pa2, pa3); partialSM<!MLA>(pB0, pB1, m_reg, mnB, alB, C, THRR, qi, kb0 + j * KVBLK, hi);
    RESC3(alB); PUBLISH(); ROT3();
    DMA_TILE(j + 2, bnext);
    SBAR(); qkt<NR>(pA0, pA1, K_lds + bcur * SHM_K, KR_lds + bcur * SHM_KR, qr, qrl, r32, hi);
    finishSM(pB0, pB1, alB, l_reg, pa0, pa1, pa2, pa3); SBAR();
    pv_d0(o, vb0 + bprev * SHM_V, pa0, pa1, pa2, pa3); partialSM<!MLA>(pA0, pA1, m_reg, mnA, alA, C, THRR, qi, kb0 + (j + 1) * KVBLK, hi);
    RESC3(alA); PUBLISH(); ROT3();
  }
  SBAR(); qkt<NR>(pB0, pB1, K_lds + bcur * SHM_K, KR_lds + bcur * SHM_KR, qr, qrl, r32, hi);
  finishSM(pA0, pA1, alA, l_reg, pa0, pa1, pa2, pa3); SBAR();
  pv_d0(o, vb0 + bprev * SHM_V, pa0, pa1, pa2, pa3); partialSM<!MLA>(pB0, pB1, m_reg, mnB, alB, C, THRR, qi, kb0 + (NT - 1) * KVBLK, hi);
  RESC3(alB);
  finishSM(pB0, pB1, alB, l_reg, pa0, pa1, pa2, pa3); SBAR();
  pv_d0(o, vb0 + bcur * SHM_V, pa0, pa1, pa2, pa3);
  if (hi == 0) li_l[r32] = l_reg; asm volatile("s_waitcnt lgkmcnt(0)" ::: "memory");
  float rli[16];
#pragma unroll
  for (int r = 0; r < 16; ++r) rli[r] = __builtin_amdgcn_rcpf(li_l[crow(r, hi)]);
  bf16* Ow = Ob + (long)(wid * QBLK) * LDQ;
#pragma unroll
  for (int r = 0; r < 16; ++r) { const int orow = crow(r, hi);
#pragma unroll
    for (int d0 = 0; d0 < 4; ++d0) { const float v = o[d0][r] * rli[r]; Ow[(long)orow * LDQ + d0 * 32 + r32] = (bf16)(cvtpk(v, v) & 0xffffu); } }
  asm volatile("s_waitcnt vmcnt(0) lgkmcnt(0)\n\ts_barrier" ::: "memory");
#undef DMA_TILE
#undef PUBLISH
#undef RESC3
#undef ROT3
}
#undef KSWZ
#undef KRSWZ
#undef SBAR
}
constexpr int NWAVES = 8;
constexpr int NB = 8, SEQ = 4096, M = NB * SEQ, D = 2048, FF = 5632, DEPTH = 2, NMOD = 9 * D, WIN_SRC = 6720, WIN_N = 6912;
constexpr float EPS = 1e-6f;
constexpr size_t MiB = 1u << 20;
constexpr size_t WS_CTL = 0, WS_MOD = 1 * MiB, WS_SS = 2 * MiB + 256 * 1024  , WS_ZERO_BYTES = 3 * MiB;
constexpr size_t WS_COSA = 4 * MiB, WS_SINA = 12 * MiB, WS_COSR = 20 * MiB, WS_SINR = 24 * MiB;
constexpr size_t WS_W = 28 * MiB;
constexpr size_t LW_GU1 = 0, LW_D1 = LW_GU1 + (size_t)2 * FF * D, LW_GU2 = LW_D1 + (size_t)FF * D, LW_D2 = LW_GU2 + (size_t)2 * FF * D, LW_IN = LW_D2 + (size_t)FF * D,
                 LW_UQ = LW_IN + (size_t)WIN_N * D, LW_UKV = LW_UQ + (size_t)1536 * 512, LW_OA = LW_UKV + (size_t)2048 * 512, LW_OB = LW_OA + (size_t)2048 * 1024,
                 LW_OUT = LW_OB + (size_t)2048 * 1024, LW_ELEMS = LW_OUT + (size_t)2048 * 2048;
static_assert(LW_ELEMS == 93585408, "weight map");
constexpr size_t WS_X16 = WS_W + ((2 * LW_ELEMS * 2 + MiB - 1) / MiB) * MiB;
constexpr size_t WS_BIG = WS_X16 + 128 * MiB;
constexpr size_t B_QA = 0  ,
                 B_KA = 128 * MiB, B_VA = 144 * MiB, B_CQN = 160 * MiB, B_CKVN = 192 * MiB, B_KR = 224 * MiB, B_GATES = 232 * MiB, B_QBR = 488 * MiB, B_KVB = 520 * MiB, B_END = 648 * MiB;
constexpr size_t B_ACT = 0, B_DELTA = 352 * MiB  ;
constexpr size_t WS_END = WS_BIG + B_END;
static_assert((size_t)M * FF * 2 <= B_END && WS_X16 == 385 * MiB, "d_ws map");
constexpr int CW_BAR = 4096;
constexpr int LDS_BYTES = 163840, LDSCTL_OFF = 162816, SCR_OFF = 65536, SCR_WAVE = 8448;
static_assert(SCR_OFF + NWAVES * SCR_WAVE <= LDSCTL_OFF && att::ATT3_LDS <= LDSCTL_OFF, "LDS map");

#define GAS __attribute__((address_space(1)))
#define LAS __attribute__((address_space(3)))
typedef unsigned short bf16;
typedef unsigned v4u __attribute__((ext_vector_type(4)));
typedef unsigned v2u __attribute__((ext_vector_type(2)));
typedef float f32x4 __attribute__((ext_vector_type(4)));
typedef _Float16 h16x4 __attribute__((ext_vector_type(4)));
#define LDS_WAIT() asm volatile("s_waitcnt lgkmcnt(0)" ::: "memory")
#define VM_WAIT() asm volatile("s_waitcnt vmcnt(0)" ::: "memory")
__device__ __forceinline__ unsigned f2bf(float f) { unsigned u = __builtin_bit_cast(unsigned, f); return (u + 0x7fffu + ((u >> 16) & 1u)) >> 16; }
__device__ __forceinline__ unsigned pk2(float lo, float hi) { return f2bf(lo) | (f2bf(hi) << 16); }
template <int CTRL> __device__ __forceinline__ float dpp_add(float v) { return v + __int_as_float(__builtin_amdgcn_update_dpp(0, __float_as_int(v), CTRL, 0xf, 0xf, true)); }
__device__ __forceinline__ float wave_sum(float v) {
    v = dpp_add<0xB1>(v);
    v = dpp_add<0x4E>(v);
    v = dpp_add<0x141>(v);
    v = dpp_add<0x140>(v);
    { auto r = __builtin_amdgcn_permlane16_swap(__float_as_uint(v), __float_as_uint(v), false, false); v = __uint_as_float(r[0]) + __uint_as_float(r[1]); }
    { auto r = __builtin_amdgcn_permlane32_swap(__float_as_uint(v), __float_as_uint(v), false, false); v = __uint_as_float(r[0]) + __uint_as_float(r[1]); }
    return v;
}
#define XB_TMO      128
#define XB_XCNT(j)  (256  + 64 * (j))
#define XB_XSUB(j)  (1280 + 64 * (j))
#define XB_XGEN(j)  (2304 + 64 * (j))
#define XB_TOP      3328
#define XB_TOPGEN   3392
#define XCD_BAR_WORDS 3456
#define XB_SPIN_CAP (1u << 18)

__device__ __forceinline__ unsigned xb_ld(unsigned* p)              { return __hip_atomic_load(p, __ATOMIC_RELAXED, __HIP_MEMORY_SCOPE_AGENT); }
__device__ __forceinline__ unsigned xb_add(unsigned* p, unsigned v) { return __hip_atomic_fetch_add(p, v, __ATOMIC_RELAXED, __HIP_MEMORY_SCOPE_AGENT); }
__device__ __forceinline__ unsigned xb_xcc_id() { return (unsigned)__builtin_amdgcn_s_getreg((3 << 11) | 20) & 0xFu; }
#define XB_SPIN(cond, bar) do { unsigned _sp = 0; while (cond) { __builtin_amdgcn_s_sleep(1); \
    if ((++_sp & 255u) == 0u) { if (xb_ld(&(bar)[XB_TMO])) break; if (_sp > XB_SPIN_CAP) { atomicAdd(&(bar)[XB_TMO], 1u); break; } } } } while (0)

struct XcdBarrier {
    unsigned* bar; unsigned x;
    unsigned wv;
    volatile LAS unsigned* st;
};

__device__ __forceinline__ XcdBarrier xcd_barrier_post(unsigned* bar, volatile LAS unsigned* st) {
    XcdBarrier b; b.bar = bar; b.x = xb_xcc_id(); b.st = st; b.wv = (unsigned)__builtin_amdgcn_readfirstlane(threadIdx.x >> 6);
    if (threadIdx.x == 0) (void)xb_add(&bar[XB_XCNT(b.x)], 1u);
    return b;
}
__device__ __forceinline__ void xcd_barrier_complete(unsigned* bar, unsigned x, unsigned& nloc, unsigned& nx) {
    const unsigned G = gridDim.x * gridDim.y * gridDim.z;
    unsigned sum, cnt, mine, sp = 0u;
    for (;;) {
        sum = 0u; cnt = 0u; mine = 0u;
#pragma unroll
        for (unsigned j = 0; j < 16; ++j) { const unsigned c = xb_ld(&bar[XB_XCNT(j)]); sum += c; cnt += (c > 0u) ? 1u : 0u; mine = (j == x) ? c : mine; }
        if (sum == G) break;
        __builtin_amdgcn_s_sleep(1);
        if ((++sp & 255u) == 0u) { if (xb_ld(&bar[XB_TMO])) break; if (sp > XB_SPIN_CAP) { atomicAdd(&bar[XB_TMO], 1u); break; } }
    }
    nloc = mine > 0u ? mine : 1u; nx = cnt > 0u ? cnt : 1u;
}

__device__ __forceinline__ void xcd_barrier(const XcdBarrier& b) {
    asm volatile("s_waitcnt vmcnt(0)" ::: "memory");
    __syncthreads();
    if (b.wv == 0u && lane_id_fresh() == 0) {
        unsigned* bar = b.bar;
        __builtin_amdgcn_s_waitcnt(0);
        unsigned nloc = b.st[0], nx = b.st[1];
        if (nloc == 0u) { xcd_barrier_complete(bar, b.x, nloc, nx); b.st[0] = nloc; b.st[1] = nx; }
        const unsigned old = xb_add(&bar[XB_XSUB(b.x)], 1u);
        const unsigned gen = old / nloc;
        if (old + 1u == (gen + 1u) * nloc) {
            __builtin_amdgcn_fence(__ATOMIC_RELEASE, "agent");
            asm volatile("s_waitcnt vmcnt(0)" ::: "memory");
            const unsigned og = xb_add(&bar[XB_TOP], 1u);
            const unsigned tg = og / nx;
            if (og + 1u == (tg + 1u) * nx) xb_add(&bar[XB_TOPGEN], 1u);
            else XB_SPIN(xb_ld(&bar[XB_TOPGEN]) == tg, bar);
            __builtin_amdgcn_fence(__ATOMIC_ACQUIRE, "agent");
            xb_add(&bar[XB_XGEN(b.x)], 1u);
            asm volatile("s_waitcnt vmcnt(0)" ::: "memory");
        } else {
            XB_SPIN(xb_ld(&bar[XB_XGEN(b.x)]) == gen, bar);
            __builtin_amdgcn_fence(__ATOMIC_ACQUIRE, "agent");
            asm volatile("s_waitcnt vmcnt(0)" ::: "memory");
        }
    }
    __syncthreads();
}
#define LOCAL_IDS() int tid_ = wave_s * 64 + lane_id_fresh(); asm volatile("" : "+v"(tid_)); const int lane = tid_ & 63, gw = vcu * NWAVES + __builtin_amdgcn_readfirstlane(tid_ >> 6), NGW = G * NWAVES
__device__ __forceinline__ int map_col(int map, int n) {
    if (map == 0) return n;
    if (map == 1) { const int t = n >> 8, j = n & 255; return j < 128 ? 128 * t + j : FF + 128 * t + (j - 128); }
    if (map == 2) {
        const int t = n >> 8, j = n & 255, bj = j >> 7, jj = j & 127;
        if (t < 4) return (2 * t + (jj >> 6)) * 128 + (jj & 63) + 64 * bj;
        if (t == 4) return 1024 + (jj >> 6) * 128 + (jj & 63) + 64 * bj;
        if (t == 5) return 1280 + j;
        if (t < 10) return 1536 + (t - 6) * 256 + j;
        if (t == 10) return jj < 32 ? 2560 + bj * 32 + jj : -1;
        return 2624 + (t - 11) * 256 + j;
    }
    {
        if (n < 1024) return (n >> 7) * 192 + (n & 127);
        const int t = (n >> 8) - 4, j = n & 255, bj = j >> 7, jj = j & 127;
        return (4 * t + (jj >> 5)) * 192 + 128 + (jj & 31) + 32 * bj;
    }
}
__device__ __forceinline__ void tr_item(const float* W, int K, int Nsrc, int Ndst, bf16* WT, int map, LAS float* scr, int item, int lane, int ldt = 0) {
    const int nblk = Ndst >> 5, kb = item / nblk, nb = item - kb * nblk, k0 = 64 * kb, n0 = 32 * nb;
    const int src = map_col(map, n0 + (lane & 31));
    const float* wp = W + (size_t)(k0 + (lane >> 5)) * Nsrc + (src < 0 ? 0 : src);
    float tv[32];
#pragma unroll
    for (int i = 0; i < 32; ++i) tv[i] = wp[(size_t)(2 * i) * Nsrc];
#pragma unroll
    for (int i = 0; i < 32; ++i) scr[(2 * i + (lane >> 5)) * 33 + (lane & 31)] = src < 0 ? 0.f : tv[i];
    LDS_WAIT(); asm volatile("" ::: "memory");
    const int c = lane & 7;
#pragma unroll
    for (int j = 0; j < 4; ++j) { const int n = (lane >> 3) + 8 * j; const LAS float* s = scr + (8 * c) * 33 + n;
        v4u o; o.x = pk2(s[0 * 33], s[1 * 33]); o.y = pk2(s[2 * 33], s[3 * 33]); o.z = pk2(s[4 * 33], s[5 * 33]); o.w = pk2(s[6 * 33], s[7 * 33]);
        *(v4u*)(WT + (size_t)(n0 + n) * (ldt ? ldt : K) + k0 + 8 * c) = o; }
    LDS_WAIT(); asm volatile("" ::: "memory");
}
__device__ __forceinline__ void sincos_d(float angf, float& s_out, float& c_out) {
    const double a = (double)angf;
    const double q = __builtin_rint(a * 0.63661977236758134308);
    double t = __builtin_fma(-q, 1.57079632679489655800, a); t = __builtin_fma(-q, 6.12323399573676603587e-17, t);
    const double t2 = t * t;
    double sp = 1.0 / 6227020800.0; sp = sp * t2 - 1.0 / 39916800.0; sp = sp * t2 + 1.0 / 362880.0; sp = sp * t2 - 1.0 / 5040.0; sp = sp * t2 + 1.0 / 120.0; sp = sp * t2 - 1.0 / 6.0; sp = sp * t2 + 1.0; sp = sp * t;
    double cp = -1.0 / 87178291200.0; cp = cp * t2 + 1.0 / 479001600.0; cp = cp * t2 - 1.0 / 3628800.0; cp = cp * t2 + 1.0 / 40320.0; cp = cp * t2 - 1.0 / 720.0; cp = cp * t2 + 1.0 / 24.0; cp = cp * t2 - 0.5; cp = cp * t2 + 1.0;
    const int qi = ((int)(long long)q) & 3;
    const double s = (qi == 0) ? sp : (qi == 1) ? cp : (qi == 2) ? -sp : -cp;
    const double c = (qi == 0) ? cp : (qi == 1) ? -sp : (qi == 2) ? -cp : sp;
    s_out = (float)s; c_out = (float)c;
}

struct P {
    const float *x, *c, *norm_g, *w_ada, *b_ada, *w_gu1, *w_d1, *w_gu2, *w_d2, *w_in, *b_gate, *sink, *g_cq, *g_ckv, *w_uq, *w_ukv, *w_oa, *w_ob, *w_out, *g_final;
    const int* pos; float* out; unsigned char* ws;
};

__device__ __forceinline__ void prologue(const P& p, LAS unsigned char* lds, int vcu, int G, const bool skip_ada, const int wave_s) {
    LOCAL_IDS(); const int tid = tid_, wave = __builtin_amdgcn_readfirstlane(tid_ >> 6);
    LAS float* cact = (LAS float*)lds;
    for (int i = tid; i < NB * D; i += NWAVES * 64) { const int b = i >> 11, k = i & 2047; const float cv = p.c[i]; cact[k * 8 + b] = cv / (1.0f + expf(-cv)); }
    __syncthreads();
    LAS float* scr = (LAS float*)(lds + SCR_OFF + wave * SCR_WAVE);
    float* mod = (float*)(p.ws + WS_MOD);
    constexpr int I_ADA = DEPTH * 72 * 8, I_TAB = M / 16;
    constexpr int I_GU = 32 * 352, I_D = 88 * 64, I_IN = 32 * (WIN_N / 32), I_UQ = 8 * 48, I_UKV = 8 * 64, I_O = 16 * 64, I_OUT = 32 * 64;
    constexpr int I_LAYER = 2 * I_GU + 2 * I_D + I_IN + I_UQ + I_UKV + 2 * I_O + I_OUT;
    constexpr int NITEMS = I_ADA + I_TAB + DEPTH * I_LAYER;
    for (int it = gw; it < NITEMS; it += NGW) {
        int r = it;
        if (r < I_ADA) { if (skip_ada) continue;
            const int l = r / 576, rr = r - l * 576, cg = rr >> 3, kc = rr & 7;
            const float* W = p.w_ada + ((size_t)l * D + 256 * kc) * NMOD + 256 * cg + 4 * lane;
            f32x4 acc[8];
#pragma unroll
            for (int b = 0; b < 8; ++b) acc[b] = (f32x4){0.f, 0.f, 0.f, 0.f};
            for (int k = 0; k < 256; k += 16) {
                f32x4 w[16];
#pragma unroll
                for (int kk = 0; kk < 16; ++kk) w[kk] = *(const f32x4*)(W + (size_t)(k + kk) * NMOD);
#pragma unroll
                for (int kk = 0; kk < 16; ++kk) { const LAS f32x4* cp = (const LAS f32x4*)(cact + (256 * kc + k + kk) * 8); const f32x4 c0 = cp[0], c1 = cp[1];
                    acc[0] += w[kk] * c0[0]; acc[1] += w[kk] * c0[1]; acc[2] += w[kk] * c0[2]; acc[3] += w[kk] * c0[3];
                    acc[4] += w[kk] * c1[0]; acc[5] += w[kk] * c1[1]; acc[6] += w[kk] * c1[2]; acc[7] += w[kk] * c1[3]; }
            }
            if (kc == 0) { const f32x4 bv = *(const f32x4*)(p.b_ada + (size_t)l * NMOD + 256 * cg + 4 * lane);
#pragma unroll
                for (int b = 0; b < 8; ++b) acc[b] += bv; }
#pragma unroll
            for (int b = 0; b < 8; ++b) { float* dst = mod + (size_t)(l * 8 + b) * NMOD + 256 * cg + 4 * lane;
#pragma unroll
                for (int i = 0; i < 4; ++i) unsafeAtomicAdd(dst + i, acc[b][i]); }
            continue;
        }
        r -= I_ADA;
        if (r < I_TAB) {
            const double ea = -(double)lane * (1.0 / 64.0), er = -(double)(lane & 31) * (1.0 / 32.0);
            const float fa = (float)exp2(ea * 13.287712379549449), fr = (float)exp2(er * 13.287712379549449);
            float* cosA = (float*)(p.ws + WS_COSA); float* sinA = (float*)(p.ws + WS_SINA); float* cosR = (float*)(p.ws + WS_COSR); float* sinR = (float*)(p.ws + WS_SINR);
            for (int i = 0; i < 16; ++i) { const int m = 16 * r + i; const float pf = (float)p.pos[m];
                float s, c; sincos_d(pf * fa, s, c); cosA[(size_t)m * 64 + lane] = c; sinA[(size_t)m * 64 + lane] = s;
                if (lane < 32) { sincos_d(pf * fr, s, c); cosR[(size_t)m * 32 + lane] = c; sinR[(size_t)m * 32 + lane] = s; } }
            continue;
        }
        r -= I_TAB;
        const int l = r >= I_LAYER ? 1 : 0; r -= l * I_LAYER;
        bf16* wl = (bf16*)(p.ws + WS_W) + (size_t)l * LW_ELEMS;
        if (r < I_GU) { tr_item(p.w_gu1 + (size_t)l * D * 2 * FF, D, 2 * FF, 2 * FF, wl + LW_GU1, 1, scr, r, lane); continue; } r -= I_GU;
        if (r < I_D)  { tr_item(p.w_d1 + (size_t)l * FF * D, FF, D, D, wl + LW_D1, 0, scr, r, lane); continue; } r -= I_D;
        if (r < I_GU) { tr_item(p.w_gu2 + (size_t)l * D * 2 * FF, D, 2 * FF, 2 * FF, wl + LW_GU2, 1, scr, r, lane); continue; } r -= I_GU;
        if (r < I_D)  { tr_item(p.w_d2 + (size_t)l * FF * D, FF, D, D, wl + LW_D2, 0, scr, r, lane); continue; } r -= I_D;
        if (r < I_IN) { tr_item(p.w_in + (size_t)l * D * WIN_SRC, D, WIN_SRC, WIN_N, wl + LW_IN, 2, scr, r, lane); continue; } r -= I_IN;
        if (r < I_UQ) { tr_item(p.w_uq + (size_t)l * 512 * 1536, 512, 1536, 1536, wl + LW_UQ, 3, scr, r, lane); continue; } r -= I_UQ;
        if (r < I_UKV) { tr_item(p.w_ukv + (size_t)l * 512 * 2048, 512, 2048, 2048, wl + LW_UKV, 0, scr, r, lane); continue; } r -= I_UKV;
        if (r < I_O)  { tr_item(p.w_oa + (size_t)l * 1024 * 2048, 1024, 2048, 2048, wl + LW_OA, 0, scr, r, lane, 2048); continue; } r -= I_O;
        if (r < I_O)  { tr_item(p.w_ob + (size_t)l * 1024 * 2048, 1024, 2048, 2048, wl + LW_OA + 1024, 0, scr, r, lane, 2048); continue; } r -= I_O;
        tr_item(p.w_out + (size_t)l * 2048 * 2048, 2048, 2048, 2048, wl + LW_OUT, 0, scr, r, lane);
    }
}

template <bool DELTA, bool FINAL, bool XI16 = false, bool XO16 = false>
__device__ __forceinline__ void thin_phase(const void* xin_, void* xout_, const bf16* delta, const float* gate, float coef, const float* g, const float* sh, const float* sc, bf16* H, int vcu, int G, const int wave_s) {
    LOCAL_IDS();
    unsigned lo16 = (unsigned)lane * 16u, lo8 = (unsigned)lane * 8u;
#define LD16(base, j) (*(const f32x4*)((const char*)(base) + lo16 + (unsigned)(j) * 1024u))
#define ST16(base, j, v) (*(f32x4*)((char*)(base) + lo16 + (unsigned)(j) * 1024u) = (v))
#define LD8(base, j) (*(const v2u*)((const char*)(base) + lo8 + (unsigned)(j) * 512u))
#define ST8(base, j, v) (*(v2u*)((char*)(base) + lo8 + (unsigned)(j) * 512u) = (v))
    for (int blk = gw; blk < M / 16; blk += NGW) {
        const int row0 = blk * 16, b = row0 >> 12;
        const float* scb = sc + (size_t)b * NMOD; const float* shb = sh + (size_t)b * NMOD; const float* gtb = gate + (size_t)b * NMOD;
        f32x4 ca[8], cs[8], cg[8];
#pragma unroll
        for (int j = 0; j < 8; ++j) { const f32x4 gv = LD16(g, j);
            if (FINAL) { ca[j] = gv; cs[j] = (f32x4){0.f, 0.f, 0.f, 0.f}; }
            else { ca[j] = gv * (LD16(scb, j) + 1.0f); cs[j] = LD16(shb, j); }
            if (DELTA) cg[j] = LD16(gtb, j) * coef; }
        for (int i = 0; i < 16; i += 2) {
            asm volatile("" : "+v"(lo16), "+v"(lo8));
            const size_t r0 = (size_t)(row0 + i) * D;
            f32x4 v0[8], v1[8]; float ss0 = 0.f, ss1 = 0.f;
            if (XI16) { const _Float16* x0 = (const _Float16*)xin_ + r0; const _Float16* x1 = x0 + D; v2u a0[8], a1[8];
#pragma unroll
                for (int j = 0; j < 8; ++j) { a0[j] = LD8(x0, j); a1[j] = LD8(x1, j); }
#pragma unroll
                for (int j = 0; j < 8; ++j) { v0[j] = __builtin_convertvector(__builtin_bit_cast(h16x4, a0[j]), f32x4); v1[j] = __builtin_convertvector(__builtin_bit_cast(h16x4, a1[j]), f32x4); } }
            else { const float* x0 = (const float*)xin_ + r0; const float* x1 = x0 + D;
#pragma unroll
                for (int j = 0; j < 8; ++j) { v0[j] = LD16(x0, j); v1[j] = LD16(x1, j); } }
            if (!DELTA && XO16 && !FINAL) { _Float16* xo0 = (_Float16*)xout_ + r0; _Float16* xo1 = xo0 + D;
#pragma unroll
                for (int j = 0; j < 8; ++j) { ST8(xo0, j, __builtin_bit_cast(v2u, __builtin_convertvector(v0[j], h16x4))); ST8(xo1, j, __builtin_bit_cast(v2u, __builtin_convertvector(v1[j], h16x4))); } }
            if (DELTA) { const bf16* dl0 = delta + r0; const bf16* dl1 = dl0 + D; v2u d0[8], d1[8];
#pragma unroll
                for (int j = 0; j < 8; ++j) { d0[j] = LD8(dl0, j); d1[j] = LD8(dl1, j); }
#pragma unroll
                for (int j = 0; j < 8; ++j) {
                    v0[j] = v0[j] + cg[j] * (f32x4){__uint_as_float(d0[j].x << 16), __uint_as_float(d0[j].x & 0xffff0000u), __uint_as_float(d0[j].y << 16), __uint_as_float(d0[j].y & 0xffff0000u)};
                    v1[j] = v1[j] + cg[j] * (f32x4){__uint_as_float(d1[j].x << 16), __uint_as_float(d1[j].x & 0xffff0000u), __uint_as_float(d1[j].y << 16), __uint_as_float(d1[j].y & 0xffff0000u)}; }
                if (!FINAL && XO16) { _Float16* xo0 = (_Float16*)xout_ + r0; _Float16* xo1 = xo0 + D;
#pragma unroll
                    for (int j = 0; j < 8; ++j) { ST8(xo0, j, __builtin_bit_cast(v2u, __builtin_convertvector(v0[j], h16x4))); ST8(xo1, j, __builtin_bit_cast(v2u, __builtin_convertvector(v1[j], h16x4))); } }
                if (!FINAL && !XO16) { float* xo0 = (float*)xout_ + r0; float* xo1 = xo0 + D;
#pragma unroll
                    for (int j = 0; j < 8; ++j) { ST16(xo0, j, v0[j]); ST16(xo1, j, v1[j]); } } }
#pragma unroll
            for (int j = 0; j < 8; ++j) { ss0 += (v0[j].x * v0[j].x + v0[j].y * v0[j].y) + (v0[j].z * v0[j].z + v0[j].w * v0[j].w); ss1 += (v1[j].x * v1[j].x + v1[j].y * v1[j].y) + (v1[j].z * v1[j].z + v1[j].w * v1[j].w); }
            const float rstd0 = 1.0f / sqrtf(wave_sum(ss0) * (1.0f / D) + EPS), rstd1 = 1.0f / sqrtf(wave_sum(ss1) * (1.0f / D) + EPS);
            if (FINAL) { float* xo0 = (float*)xout_ + r0; float* xo1 = xo0 + D;
#pragma unroll
                for (int j = 0; j < 8; ++j) { ST16(xo0, j, v0[j] * rstd0 * ca[j]); ST16(xo1, j, v1[j] * rstd1 * ca[j]); } }
            else { bf16* h0p = H + r0; bf16* h1p = h0p + D;
#pragma unroll
                for (int j = 0; j < 8; ++j) { const f32x4 h0 = v0[j] * rstd0 * ca[j] + cs[j], h1 = v1[j] * rstd1 * ca[j] + cs[j]; v2u w0, w1; w0.x = pk2(h0.x, h0.y); w0.y = pk2(h0.z, h0.w); w1.x = pk2(h1.x, h1.y); w1.y = pk2(h1.z, h1.w); ST8(h0p, j, w0); ST8(h1p, j, w1); } }
        }
    }
#undef LD16
#undef ST16
#undef LD8
#undef ST8
}
#ifndef EN_PRO
#define EN_PRO 1
#endif
#ifndef EN_ATT
#define EN_ATT 1
#endif
#ifndef EN_G1
#define EN_G1 1
#endif
#ifndef EN_G2
#define EN_G2 1
#endif
#ifndef EN_G4
#define EN_G4 1
#endif
#ifndef EN_G6
#define EN_G6 1
#endif
#ifndef EN_G8
#define EN_G8 1
#endif
#ifndef EN_G9
#define EN_G9 1
#endif
#ifndef EN_G11
#define EN_G11 1
#endif
#ifndef EN_G12
#define EN_G12 1
#endif
struct Args { const void* in[21]; float* out; unsigned char* ws; int ph_lo, ph_hi; };
#ifndef ALIGN_WIN
#define ALIGN_WIN true
#endif
#ifndef GEMM_ALIGN
#define GEMM_ALIGN true
#endif
#ifndef GEMM_SP2
#define GEMM_SP2 true
#endif
#ifndef WGM_S
#define WGM_S 8
#endif
#ifndef REV_D
#define REV_D 0
#endif
#ifndef WGM_GU
#define WGM_GU 8
#endif
#ifndef WGM_WIN
#define WGM_WIN 8
#endif
#ifndef WGM_D
#define WGM_D 4
#endif
#ifndef FCH
#define FCH 1
#endif
constexpr int MC = M / FCH;
enum { P_N1 = 0, P_F1 = 1, P_N2 = P_F1 + FCH + 1, P_WIN, P_UQ, P_ATT, P_OAB, P_WOUT, P_N3, P_F2, PH_PER_LAYER = P_F2 + FCH + 1 };
constexpr int N_PHASES = 2 + DEPTH * PH_PER_LAYER;

__global__ void __launch_bounds__(NWAVES * 64, 2) mega_fwd(Args args) {
    extern __shared__ __attribute__((aligned(16))) unsigned char lds_raw[];
    LAS unsigned char* lds = (LAS unsigned char*)lds_raw;
    const int tid = threadIdx.x; const int wave_s = __builtin_amdgcn_readfirstlane(tid >> 6);
    const int G = gridDim.x, bx = blockIdx.x, vcu = (G % 8 == 0) ? (bx % 8) * (G / 8) + bx / 8 : bx;
    P p;
    p.x = (const float*)args.in[0]; p.c = (const float*)args.in[1]; p.pos = (const int*)args.in[2]; p.norm_g = (const float*)args.in[3]; p.w_ada = (const float*)args.in[4]; p.b_ada = (const float*)args.in[5];
    p.w_gu1 = (const float*)args.in[6]; p.w_d1 = (const float*)args.in[7]; p.w_gu2 = (const float*)args.in[8]; p.w_d2 = (const float*)args.in[9]; p.w_in = (const float*)args.in[10]; p.b_gate = (const float*)args.in[11];
    p.sink = (const float*)args.in[12]; p.g_cq = (const float*)args.in[13]; p.g_ckv = (const float*)args.in[14]; p.w_uq = (const float*)args.in[15]; p.w_ukv = (const float*)args.in[16];
    p.w_oa = (const float*)args.in[17]; p.w_ob = (const float*)args.in[18]; p.w_out = (const float*)args.in[19]; p.g_final = (const float*)args.in[20];
    p.out = args.out; p.ws = args.ws;
    unsigned char* ws = args.ws;
    for (int u = tid; u < (LDS_BYTES - LDSCTL_OFF) / 4; u += NWAVES * 64) ((LAS unsigned*)(lds + LDSCTL_OFF))[u] = 0u;
    __syncthreads();
    const int lo = args.ph_lo, hi = args.ph_hi;
    XcdBarrier bar; bar.bar = (unsigned*)(ws + WS_CTL) + CW_BAR; bar.x = 0; bar.st = nullptr;
    if (hi - lo > 1) bar = xcd_barrier_post((unsigned*)(ws + WS_CTL) + CW_BAR, (volatile LAS unsigned*)(lds + LDSCTL_OFF) + 8);
#define IN(k) (lo <= (k) && (k) < hi)
#define SEAM(k) do { if (IN(k) && IN((k) + 1)) xcd_barrier(bar); } while (0)

#define WSL() ({ unsigned long long w_ = (unsigned long long)ws; asm volatile("" : "+s"(w_)); (unsigned char*)(GAS unsigned char*)w_; })
#define mod   ((float*)(WSL() + WS_MOD))
#define cosA  ((const float*)(WSL() + WS_COSA))
#define sinA  ((const float*)(WSL() + WS_SINA))
#define cosR  ((const float*)(WSL() + WS_COSR))
#define sinR  ((const float*)(WSL() + WS_SINR))
#define H     ((bf16*)p.out)
#define X16   ((_Float16*)(WSL() + WS_X16))
#define big   (WSL() + WS_BIG)
#define ACT   ((bf16*)(big + B_ACT))
#define QA    ((bf16*)(big + B_QA))
#define KA    ((bf16*)(big + B_KA))
#define VA    ((bf16*)(big + B_VA))
#define CQN   ((bf16*)(big + B_CQN))
#define CKVN  ((bf16*)(big + B_CKVN))
#define KR    ((bf16*)(big + B_KR))
#define GATES ((unsigned char*)(big + B_GATES))
#define QBN   ((bf16*)(big + B_QA) + 1024)
#define QBR   ((bf16*)(big + B_QBR))
#define KVB   ((bf16*)(big + B_KVB))
#define MIX   H
#define DELTA ((bf16*)(big + B_DELTA))
#define SSQ   ((float*)(WSL() + WS_SS) + (size_t)(2 * l) * M)
#define SSKV  ((float*)(WSL() + WS_SS) + (size_t)(2 * l + 1) * M)

    if (EN_PRO && IN(0)) { prologue(p, lds, vcu, G, false, wave_s); VM_WAIT(); __syncthreads();
    }
    SEAM(0);

#pragma unroll 1
    for (int l = 0; l < DEPTH; ++l) {
        const int pb = 1 + l * PH_PER_LAYER;
#define wl ((const bf16*)(WSL() + WS_W) + (size_t)l * LW_ELEMS)
#define ml (mod + (size_t)l * 8 * NMOD)
        const float* ng = p.norm_g + (size_t)l * 3 * D;
        if (IN(pb + P_N1)) { if (l == 0) thin_phase<false, false, false, true>(p.x, X16, DELTA, ml, 0.f, ng, ml + 0 * D, ml + 1 * D, H, vcu, G, wave_s);
                             else thin_phase<false, false, true, false>(X16, X16, DELTA, ml, 0.f, ng, ml + 0 * D, ml + 1 * D, H, vcu, G, wave_s); }
        SEAM(pb + P_N1);
#pragma unroll 1
        for (int s_ = 0; s_ <= FCH; ++s_) {
            if (IN(pb + P_F1 + s_)) {
                if (s_ > 0) { const int c_ = s_ - 1; pg8::Gemm g{ACT + (size_t)c_ * MC * FF, wl + LW_D1, MC, D, FF}; pg8::StaticOrder S; S.init(MC, D, G, bx, WGM_D); S.rev = REV_D;
                    pg8::EpiResid16 E{X16 + (size_t)c_ * MC * D, ml + 2 * D + (size_t)((c_ * MC) >> 12) * NMOD, NMOD, 0.5f};
                    pg8::gemm_phase<pg8::EpiResid16, pg8::StaticOrder, GEMM_ALIGN, GEMM_SP2>(lds, g, S, E, wave_s); }
                if (s_ < FCH) { const int c_ = s_; pg8::Gemm g{H + (size_t)c_ * MC * D, wl + LW_GU1, MC, 2 * FF, D}; pg8::StaticOrder S; S.init(MC, 2 * FF, G, bx, WGM_GU); pg8::EpiSwiglu E{ACT + (size_t)c_ * MC * FF, FF};
                    pg8::gemm_phase<pg8::EpiSwiglu, pg8::StaticOrder, GEMM_ALIGN, GEMM_SP2>(lds, g, S, E, wave_s); }
            }
            SEAM(pb + P_F1 + s_);
        }
        if (IN(pb + P_N2)) thin_phase<false, false, true, false>(X16, X16, DELTA, ml, 0.f, ng + D, ml + 3 * D, ml + 4 * D, H, vcu, G, wave_s);
        SEAM(pb + P_N2);
        if (IN(pb + P_WIN)) { pg8::Gemm g{H, wl + LW_IN, M, WIN_N, D}; pg8::StaticOrder S; S.init(M, WIN_N, G, bx, WGM_WIN);
            pg8::EpiWin E{QA, KA, VA, KR, GATES, CQN, CKVN, SSQ, SSKV, p.g_cq + l * 512, p.g_ckv + l * 512, cosA, sinA, cosR, sinR, p.b_gate + (size_t)l * 2 * D};
            pg8::gemm_phase<pg8::EpiWin, pg8::StaticOrder, ALIGN_WIN, GEMM_SP2>(lds, g, S, E, wave_s); }
        SEAM(pb + P_WIN);
        if (IN(pb + P_UQ)) {
            { pg8::Gemm g{CQN, wl + LW_UQ, M, 1536, 512}; pg8::StaticOrder S; S.init(M, 1536, G, bx); pg8::EpiUq E{QBN, QBR, cosR, sinR, SSQ};
              pg8::gemm_phase<pg8::EpiUq, pg8::StaticOrder, GEMM_ALIGN, GEMM_SP2>(lds, g, S, E, wave_s); }
            { pg8::Gemm g{CKVN, wl + LW_UKV, M, 2048, 512}; pg8::StaticOrder S; S.init(M, 2048, G, bx, WGM_S); pg8::EpiScaledBf16 E{KVB, 2048, SSKV};
              pg8::gemm_phase<pg8::EpiScaledBf16, pg8::StaticOrder, GEMM_ALIGN, GEMM_SP2>(lds, g, S, E, wave_s); }
        }
        SEAM(pb + P_UQ);
        if (IN(pb + P_ATT)) {
            for (int u = vcu; u < NB * 8 * 16; u += G) { const int bh = u >> 4, qb = u & 15, b = bh >> 3, h = bh & 7; const size_t r0 = (size_t)b * SEQ + qb * 256, k0 = (size_t)b * SEQ;
                att::attn_body_dma<true, 2048, 512, 2048>(QBN + r0 * 2048 + h * 128, QBR + r0 * 512 + h * 64, KVB + k0 * 2048 + h * 256, KVB + k0 * 2048 + h * 256 + 128, KR + k0 * 64,
                                                      QBN + r0 * 2048 + h * 128, SEQ / 64, 0.07216878364870322f * 1.4426950408889634f, 8.0f / 0.07216878364870322f, -1e30f, 0.f, 0, 0, (char*)lds_raw, wave_s); }
            for (int u = vcu; u < NB * 8 * 16; u += G) { const int bh = u >> 4, qb = u & 15, b = bh >> 3, h = bh & 7, i0 = qb * 256; const size_t r0 = (size_t)b * SEQ + i0;
                const int klo = i0 >= 128 ? i0 - 128 : 0, khi = i0 + 384 <= SEQ ? i0 + 384 : SEQ; const size_t k0 = (size_t)b * SEQ + klo;
                const float sk = p.sink[l * 8 + h];
                att::attn_body_dma<false, 2048, 512, 256>(QA + r0 * 2048 + h * 128, nullptr, KA + k0 * 256 + (h >> 2) * 128, VA + k0 * 256 + (h >> 2) * 128, nullptr,
                                                      QA + r0 * 2048 + h * 128, (khi - klo) / 64, 0.08838834764831845f * 1.4426950408889634f, 8.0f / 0.08838834764831845f, sk / 0.08838834764831845f, 1.f, i0, klo, (char*)lds_raw, wave_s); }
        }
        SEAM(pb + P_ATT);
        if (IN(pb + P_OAB)) { pg8::Gemm g{QA, wl + LW_OA, M, D, 2048}; pg8::StaticOrder S; S.init(M, D, G, bx, WGM_S); pg8::EpiGateMerge E{GATES, MIX};
            pg8::gemm_phase<pg8::EpiGateMerge, pg8::StaticOrder, GEMM_ALIGN, GEMM_SP2>(lds, g, S, E, wave_s); }
        SEAM(pb + P_OAB);
        if (IN(pb + P_WOUT)) { pg8::Gemm g{MIX, wl + LW_OUT, M, D, D}; pg8::StaticOrder S; S.init(M, D, G, bx, WGM_S); pg8::EpiResid16 E{X16, ml + 5 * D, NMOD, 1.0f};
            pg8::gemm_phase<pg8::EpiResid16, pg8::StaticOrder, GEMM_ALIGN, GEMM_SP2>(lds, g, S, E, wave_s); }
        SEAM(pb + P_WOUT);
        if (IN(pb + P_N3)) thin_phase<false, false, true, false>(X16, X16, DELTA, ml, 0.f, ng + 2 * D, ml + 6 * D, ml + 7 * D, H, vcu, G, wave_s);
        SEAM(pb + P_N3);
#pragma unroll 1
        for (int s_ = 0; s_ <= FCH; ++s_) {
            if (IN(pb + P_F2 + s_)) {
                if (s_ > 0) { const int c_ = s_ - 1; pg8::Gemm g{ACT + (size_t)c_ * MC * FF, wl + LW_D2, MC, D, FF}; pg8::StaticOrder S; S.init(MC, D, G, bx, WGM_D); S.rev = REV_D;
                    pg8::EpiResid16 E{X16 + (size_t)c_ * MC * D, ml + 8 * D + (size_t)((c_ * MC) >> 12) * NMOD, NMOD, 0.5f};
                    pg8::gemm_phase<pg8::EpiResid16, pg8::StaticOrder, GEMM_ALIGN, GEMM_SP2>(lds, g, S, E, wave_s); }
                if (s_ < FCH) { const int c_ = s_; pg8::Gemm g{H + (size_t)c_ * MC * D, wl + LW_GU2, MC, 2 * FF, D}; pg8::StaticOrder S; S.init(MC, 2 * FF, G, bx, WGM_GU); pg8::EpiSwiglu E{ACT + (size_t)c_ * MC * FF, FF};
                    pg8::gemm_phase<pg8::EpiSwiglu, pg8::StaticOrder, GEMM_ALIGN, GEMM_SP2>(lds, g, S, E, wave_s); }
            }
            SEAM(pb + P_F2 + s_);
        }
    }
    if (IN(N_PHASES - 1)) thin_phase<false, true, true, false>(X16, p.out, DELTA, mod, 0.f, p.g_final, p.g_final, p.g_final, H, vcu, G, wave_s);
#undef IN
#undef SEAM
}

extern "C" void kernel_launch(void* const* d_in, const int* in_sizes, int n_in, void* d_out, int out_size, void* d_ws, size_t ws_size, hipStream_t stream) {
    static int grid = 0;
    if (grid == 0) {
        if (n_in != 21 || in_sizes[0] != M * D || out_size != M * D || ws_size < WS_END) {
            fprintf(stderr, "kernel_launch: built for 21 inputs, x/out of %d floats, >= %zu bytes of workspace; got n_in %d, in0 %d, out %d, ws %zu; nothing launched\n", M * D, (size_t)WS_END, n_in, n_in > 0 ? in_sizes[0] : -1, out_size, ws_size);
            grid = -1; return; }
        int dev = 0, cus = 0, per_cu = 0;
        if (hipGetDevice(&dev) != hipSuccess || hipDeviceGetAttribute(&cus, hipDeviceAttributeMultiprocessorCount, dev) != hipSuccess) { fprintf(stderr, "kernel_launch: device query failed\n"); grid = -1; return; }
        if (hipFuncSetAttribute((const void*)mega_fwd, hipFuncAttributeMaxDynamicSharedMemorySize, LDS_BYTES) != hipSuccess) { fprintf(stderr, "kernel_launch: hipFuncSetAttribute failed\n"); grid = -1; return; }
        if (hipOccupancyMaxActiveBlocksPerMultiprocessor(&per_cu, (const void*)mega_fwd, NWAVES * 64, LDS_BYTES) != hipSuccess || per_cu < 1)
            fprintf(stderr, "kernel_launch: note: occupancy query reports %d workgroups per CU\n", per_cu);
        (void)hipGetLastError();
        grid = cus;
    }
    if (grid < 0) return;
    if (hipMemsetAsync((char*)d_ws + WS_CTL, 0, WS_ZERO_BYTES, stream) != hipSuccess) { fprintf(stderr, "kernel_launch: memset failed\n"); return; }
    Args a{};
    for (int i = 0; i < 21; ++i) a.in[i] = d_in[i];
    a.out = (float*)d_out; a.ws = (unsigned char*)d_ws;
#if MK_ONE_LAUNCH
    a.ph_lo = 0; a.ph_hi = N_PHASES;
    hipLaunchKernelGGL(mega_fwd, dim3(grid), dim3(NWAVES * 64), LDS_BYTES, stream, a);
#else
    for (int ph = 0; ph < N_PHASES; ++ph) { a.ph_lo = ph; a.ph_hi = ph + 1;
        hipLaunchKernelGGL(mega_fwd, dim3(grid), dim3(NWAVES * 64), LDS_BYTES, stream, a);
    }
#endif
    const hipError_t le = hipPeekAtLastError();
    if (le != hipSuccess) fprintf(stderr, "kernel_launch: launch failed: %s\n", hipGetErrorName(le));
}
```
